# Optimizing an MI355X kernel written in HIP

```python
import jax, jax.numpy as jnp
from jax import lax
import numpy as np

D_MODEL = 1024
BATCH = 8
SEQ = 2048
DEPTH = 2

W_POOL = D_MODEL // 2
W_SSM = D_MODEL // 2
W_LRU = D_MODEL // 2
W_GMLP = D_MODEL // 2
N_BRANCH = 4
W_BRANCH = D_MODEL // 2
POOL_WINDOWS = (2, 4, 8, 16)
POOL_GROUPS = 4
POOL_GC = W_POOL // POOL_GROUPS
SSM_H = 16
SSM_G = W_SSM // SSM_H
SSM_P = 64
SSM_DT_MIN = 1e-3
SSM_DT_MAX = 1e-1
LRU_BLOCKS = 8
LRU_BC = W_LRU // LRU_BLOCKS
LRU_C = 8.0
CONV_W = 4
GMLP_CHUNK = 128
GMLP_GROUPS = 4
GMLP_GC = W_GMLP // GMLP_GROUPS
D_FF = 4 * D_MODEL
D_IN = W_POOL + W_SSM + 2 * W_LRU + 2 * W_GMLP
SPLITS = (W_POOL, W_POOL + W_SSM, W_POOL + W_SSM + W_LRU, W_POOL + W_SSM + 2 * W_LRU)
EPS = 1e-6

kernel_name = 'hybrid_gated_bidir_encoder'


def rmsnorm(x, g):
    xf = x.astype(jnp.float32)
    r = lax.rsqrt(jnp.mean(xf * xf, axis=-1, keepdims=True) + EPS)
    return (xf * r).astype(x.dtype) * g


def _real_combine(e1, e2):
    a1, b1 = e1
    a2, b2 = e2
    return a2 * a1, a2 * b1 + b2


def _cplx_combine(e1, e2):
    a1r, a1i, b1r, b1i = e1
    a2r, a2i, b2r, b2i = e2
    return (a2r * a1r - a2i * a1i,
            a2r * a1i + a2i * a1r,
            a2r * b1r - a2i * b1i + b2r,
            a2r * b1i + a2i * b1r + b2i)


def pool_mixer(u, w_pool, s_pool):
    Bsz, L, _ = u.shape
    ug = u.reshape(Bsz, L, POOL_GROUPS, POOL_GC)
    cs = jnp.cumsum(ug.astype(jnp.float32), axis=1)
    cs = jnp.pad(cs, ((0, 0), (1, 0), (0, 0), (0, 0)))
    t = jnp.arange(L)[:, None]
    win = jnp.array(POOL_WINDOWS, dtype=jnp.int32)[None, :]
    lo = jnp.clip(t - win // 2, 0, L)
    hi = jnp.clip(t - win // 2 + win, 0, L)
    gi = jnp.arange(POOL_GROUPS)[None, :]
    wsum = cs[:, hi, gi] - cs[:, lo, gi]
    cnt = (hi - lo).astype(jnp.float32)[None, :, :, None]
    pooled = (wsum / cnt).astype(u.dtype) - ug
    y = jnp.einsum('blgc,gcd->blgd', pooled, w_pool)
    return y.reshape(Bsz, L, W_POOL) * s_pool


def ssm_mixer(u, lam_re, lam_im, log_dt, b_re, b_im, c_re, c_im, d_skip, glu_w, glu_b):
    Bsz, L, _ = u.shape
    ug = u.reshape(Bsz, L, SSM_G, SSM_H).astype(jnp.float32)
    lr = lam_re.astype(jnp.float32)
    li = lam_im.astype(jnp.float32)
    dt = jnp.exp(log_dt.astype(jnp.float32))[..., None]
    mag = jnp.exp(lr * dt)
    ab_re = mag * jnp.cos(li * dt)
    ab_im = mag * jnp.sin(li * dt)
    den = lr * lr + li * li
    nr = ab_re - 1.0
    f_re = (nr * lr + ab_im * li) / den
    f_im = (ab_im * lr - nr * li) / den
    br = b_re.astype(jnp.float32)[None]
    bi = b_im.astype(jnp.float32)[None]
    bb_re = f_re[..., None] * br - f_im[..., None] * bi
    bb_im = f_re[..., None] * bi + f_im[..., None] * br
    y = ug * d_skip.astype(jnp.float32).reshape(SSM_G, SSM_H)
    for dirn, rev in ((0, False), (1, True)):
        x_re = jnp.einsum('blgh,gph->blgp', ug, bb_re[dirn])
        x_im = jnp.einsum('blgh,gph->blgp', ug, bb_im[dirn])
        a_re = jnp.broadcast_to(ab_re[dirn], x_re.shape)
        a_im = jnp.broadcast_to(ab_im[dirn], x_im.shape)
        _, _, h_re, h_im = lax.associative_scan(_cplx_combine, (a_re, a_im, x_re, x_im), reverse=rev, axis=1)
        y = y + jnp.einsum('blgp,ghp->blgh', h_re, c_re[dirn].astype(jnp.float32)) \
              - jnp.einsum('blgp,ghp->blgh', h_im, c_im[dirn].astype(jnp.float32))
    y = jax.nn.gelu(y.reshape(Bsz, L, W_SSM)).astype(u.dtype)
    return y * jax.nn.sigmoid(y @ glu_w + glu_b)


def rglru_mixer(xr, xg, conv_w, conv_b, w_a, b_a, w_x, b_x, lam):
    Bsz, L, _ = xr.shape
    left = CONV_W // 2
    xp = jnp.pad(xr, ((0, 0), (left, CONV_W - 1 - left), (0, 0)))
    xc = conv_b + sum(xp[:, k:k + L] * conv_w[k] for k in range(CONV_W))
    xb = xc.reshape(Bsz, L, LRU_BLOCKS, LRU_BC)
    xcf = xc.astype(jnp.float32)
    h = jnp.zeros_like(xcf)
    for dirn, rev in ((0, False), (1, True)):
        r = jax.nn.sigmoid(jnp.einsum('blkc,kcd->blkd', xb, w_a[dirn]).reshape(Bsz, L, W_LRU) + b_a[dirn])
        i = jax.nn.sigmoid(jnp.einsum('blkc,kcd->blkd', xb, w_x[dirn]).reshape(Bsz, L, W_LRU) + b_x[dirn])
        log_a = LRU_C * r.astype(jnp.float32) * jax.nn.log_sigmoid(lam[dirn].astype(jnp.float32))
        a = jnp.exp(log_a)
        mult = jnp.sqrt(-jnp.expm1(2.0 * log_a))
        xin = mult * i.astype(jnp.float32) * xcf
        _, hh = lax.associative_scan(_real_combine, (a, xin), reverse=rev, axis=1)
        h = h + hh
    return h.astype(xr.dtype) * jax.nn.gelu(xg)


def gmlp_mixer(z, norm_g, w_s, b_s):
    Bsz, L, _ = z.shape
    u, v = jnp.split(jax.nn.gelu(z), 2, axis=-1)
    v = rmsnorm(v, norm_g)
    vc = v.reshape(Bsz, L // GMLP_CHUNK, GMLP_CHUNK, GMLP_GROUPS, GMLP_GC)
    sv = jnp.einsum('gqp,bnpgc->bnqgc', w_s, vc) + b_s.T[None, None, :, :, None]
    return u * sv.reshape(Bsz, L, W_GMLP)


def setup_inputs(seed: int = 0) -> dict:
    key = jax.random.key(seed)
    it = iter(jax.random.split(key, 48))
    nk = lambda: next(it)
    f32 = jnp.float32

    def nrm(shape, scale):
        return jax.random.normal(nk(), shape, f32) * scale

    def gain(shape):
        return 1.0 + 0.05 * jax.random.normal(nk(), shape, f32)

    Dp = DEPTH
    n_idx = jnp.arange(SSM_P, dtype=f32)
    lam_re = -0.5 + 0.01 * jax.random.normal(nk(), (Dp, 2, SSM_G, SSM_P), f32)
    lam_im = jnp.pi * n_idx + 0.01 * jax.random.normal(nk(), (Dp, 2, SSM_G, SSM_P), f32)
    log_dt = jax.random.uniform(nk(), (Dp, 2, SSM_G), f32, np.log(SSM_DT_MIN), np.log(SSM_DT_MAX))
    a0 = jax.random.uniform(nk(), (Dp, 2, W_LRU), f32, 0.9, 0.999)
    s0 = a0 ** (1.0 / LRU_C)
    lru_lam = jnp.log(s0) - jnp.log1p(-s0)
    return {
        'x': nrm((BATCH, SEQ, D_MODEL), 1.0),
        'c': nrm((BATCH, D_MODEL), 1.0),
        'ada_w': nrm((Dp, D_MODEL, 6 * D_MODEL), 0.5 * D_MODEL ** -0.5),
        'ada_b': nrm((Dp, 6 * D_MODEL), 0.02),
        'norm1_g': gain((Dp, D_MODEL)),
        'w_in': nrm((Dp, D_MODEL, D_IN), D_MODEL ** -0.5),
        'pool_w': nrm((Dp, POOL_GROUPS, POOL_GC, POOL_GC), POOL_GC ** -0.5),
        'pool_scale': gain((Dp, W_POOL)),
        'ssm_lam_re': lam_re,
        'ssm_lam_im': lam_im,
        'ssm_log_dt': log_dt,
        'ssm_b_re': nrm((Dp, SSM_G, SSM_P, SSM_H), (2 * SSM_H) ** -0.5),
        'ssm_b_im': nrm((Dp, SSM_G, SSM_P, SSM_H), (2 * SSM_H) ** -0.5),
        'ssm_c_re': nrm((Dp, 2, SSM_G, SSM_H, SSM_P), (2 * SSM_P) ** -0.5),
        'ssm_c_im': nrm((Dp, 2, SSM_G, SSM_H, SSM_P), (2 * SSM_P) ** -0.5),
        'ssm_d': nrm((Dp, W_SSM), 0.5),
        'ssm_glu_w': nrm((Dp, W_SSM, W_SSM), W_SSM ** -0.5),
        'ssm_glu_b': nrm((Dp, W_SSM), 0.02),
        'lru_conv_w': nrm((Dp, CONV_W, W_LRU), CONV_W ** -0.5),
        'lru_conv_b': nrm((Dp, W_LRU), 0.02),
        'lru_wa': nrm((Dp, 2, LRU_BLOCKS, LRU_BC, LRU_BC), LRU_BC ** -0.5),
        'lru_ba': nrm((Dp, 2, W_LRU), 0.02),
        'lru_wx': nrm((Dp, 2, LRU_BLOCKS, LRU_BC, LRU_BC), LRU_BC ** -0.5),
        'lru_bx': nrm((Dp, 2, W_LRU), 0.02),
        'lru_lam': lru_lam,
        'gmlp_norm_g': gain((Dp, W_GMLP)),
        'gmlp_ws': nrm((Dp, GMLP_GROUPS, GMLP_CHUNK, GMLP_CHUNK), 0.5 * GMLP_CHUNK ** -0.5),
        'gmlp_bs': gain((Dp, GMLP_GROUPS, GMLP_CHUNK)),
        'w_branch': nrm((Dp, N_BRANCH, W_BRANCH, D_MODEL), W_BRANCH ** -0.5),
        'w_gate': nrm((Dp, D_MODEL, N_BRANCH * D_MODEL), D_MODEL ** -0.5),
        'b_gate': nrm((Dp, N_BRANCH * D_MODEL), 0.02),
        'w_out': nrm((Dp, D_MODEL, D_MODEL), D_MODEL ** -0.5),
        'norm2_g': gain((Dp, D_MODEL)),
        'w_ff1': nrm((Dp, D_MODEL, D_FF), D_MODEL ** -0.5),
        'w_ff2': nrm((Dp, D_FF, D_MODEL), D_FF ** -0.5),
        'final_g': gain((D_MODEL,)),
    }


def reference(x, c, ada_w, ada_b, norm1_g, w_in, pool_w, pool_scale,
              ssm_lam_re, ssm_lam_im, ssm_log_dt, ssm_b_re, ssm_b_im, ssm_c_re, ssm_c_im,
              ssm_d, ssm_glu_w, ssm_glu_b,
              lru_conv_w, lru_conv_b, lru_wa, lru_ba, lru_wx, lru_bx, lru_lam,
              gmlp_norm_g, gmlp_ws, gmlp_bs,
              w_branch, w_gate, b_gate, w_out, norm2_g, w_ff1, w_ff2, final_g):
    Bsz, L, _ = x.shape
    cond = jax.nn.silu(c)
    for l in range(DEPTH):
        mod = cond @ ada_w[l] + ada_b[l]
        sh1, sc1, g1, sh2, sc2, g2 = [m[:, None, :] for m in jnp.split(mod, 6, axis=-1)]
        h = rmsnorm(x, norm1_g[l]) * (1.0 + sc1) + sh1
        z = h @ w_in[l]
        zp, zs, zr, zg, zm = jnp.split(z, SPLITS, axis=-1)
        ya = pool_mixer(zp, pool_w[l], pool_scale[l])
        yb = ssm_mixer(zs, ssm_lam_re[l], ssm_lam_im[l], ssm_log_dt[l], ssm_b_re[l], ssm_b_im[l],
                       ssm_c_re[l], ssm_c_im[l], ssm_d[l], ssm_glu_w[l], ssm_glu_b[l])
        yc = rglru_mixer(zr, zg, lru_conv_w[l], lru_conv_b[l], lru_wa[l], lru_ba[l],
                         lru_wx[l], lru_bx[l], lru_lam[l])
        yd = gmlp_mixer(zm, gmlp_norm_g[l], gmlp_ws[l], gmlp_bs[l])
        ys = jnp.stack([ya, yb, yc, yd], axis=2)
        proj = jnp.einsum('blkw,kwd->blkd', ys, w_branch[l])
        gates = jax.nn.sigmoid(h @ w_gate[l] + b_gate[l]).reshape(Bsz, L, N_BRANCH, D_MODEL)
        merged = jnp.einsum('blkd,blkd->bld', gates, proj)
        x = x + g1 * (merged @ w_out[l])
        h2 = rmsnorm(x, norm2_g[l]) * (1.0 + sc2) + sh2
        f = jnp.square(jax.nn.relu(h2 @ w_ff1[l])) @ w_ff2[l]
        x = x + g2 * f
    return rmsnorm(x, final_g)
```

```cpp
#include <hip/hip_runtime.h>
#include <stdint.h>
#include <stdio.h>

namespace {
constexpr int DM = 1024, NB = 8, SEQ = 2048, M = NB * SEQ, DEPTH = 2;
constexpr int DIN = 3072, DFF = 4096, WB = 512;
constexpr float EPS = 1e-6f;
typedef uint16_t bf16;

__device__ __forceinline__ bf16 f2bf(float f) { unsigned u = __builtin_bit_cast(unsigned, f); return (bf16)((u + 0x7fffu + ((u >> 16) & 1u)) >> 16); }
__device__ __forceinline__ float bf2f(bf16 h) { return __builtin_bit_cast(float, (unsigned)h << 16); }
__device__ __forceinline__ float sigmoidf_(float x) { return 1.f / (1.f + expf(-x)); }
__device__ __forceinline__ float gelu_(float x) { const float u = 0.7978845608028654f * (x + 0.044715f * x * x * x); return x / (1.f + expf(-2.f * u)); }
__device__ __forceinline__ float wave_sum(float v) {
#pragma unroll
    for (int o = 1; o < 64; o <<= 1) v += __shfl_xor(v, o);
    return v;
}

constexpr size_t MiB = 1u << 20;
constexpr size_t WS_MOD = 0;
constexpr size_t WS_RS = 512 * 1024;
constexpr size_t WS_H = 1 * MiB;
constexpr size_t WS_Z = 33 * MiB;
constexpr size_t WS_YS = 129 * MiB;
constexpr size_t WS_YSSM = 193 * MiB;
constexpr size_t WS_MERGED = 209 * MiB;
constexpr size_t WS_F1 = 33 * MiB;
constexpr size_t WS_END = 241 * MiB;

__device__ __forceinline__ void gemm_acc(const bf16* A, int lda, const float* W, int ldw, int K, int m0, int n0, float (&acc)[4][4], float (*As)[68], float (*Ws)[68]) {
    const int tid = threadIdx.x, tx = tid & 15, ty = tid >> 4;
    for (int k0 = 0; k0 < K; k0 += 16) {
        {
            const int r = tid >> 2, kc = (tid & 3) * 4;
            const bf16* ap = A + (size_t)(m0 + r) * lda + k0 + kc;
            const uint2 raw = *(const uint2*)ap;
            As[kc + 0][r] = bf2f((bf16)(raw.x & 0xffff)); As[kc + 1][r] = bf2f((bf16)(raw.x >> 16));
            As[kc + 2][r] = bf2f((bf16)(raw.y & 0xffff)); As[kc + 3][r] = bf2f((bf16)(raw.y >> 16));
            const int kr = tid >> 4, nc = (tid & 15) * 4;
            const float4 w = *(const float4*)(W + (size_t)(k0 + kr) * ldw + n0 + nc);
            Ws[kr][nc] = w.x; Ws[kr][nc + 1] = w.y; Ws[kr][nc + 2] = w.z; Ws[kr][nc + 3] = w.w;
        }
        __syncthreads();
#pragma unroll
        for (int k = 0; k < 16; ++k) {
            float a[4], b[4];
#pragma unroll
            for (int i = 0; i < 4; ++i) { a[i] = As[k][ty * 4 + i]; b[i] = Ws[k][tx * 4 + i]; }
#pragma unroll
            for (int i = 0; i < 4; ++i)
#pragma unroll
                for (int j = 0; j < 4; ++j) acc[i][j] = fmaf(a[i], b[j], acc[i][j]);
        }
        __syncthreads();
    }
}
#define GEMM_DECL __shared__ float As[16][68]; __shared__ float Ws[16][68]; float acc[4][4]; for (int i = 0; i < 4; ++i) for (int j = 0; j < 4; ++j) acc[i][j] = 0.f; \
    const int tx = threadIdx.x & 15, ty = threadIdx.x >> 4; const int m0 = blockIdx.y * 64, n0 = blockIdx.x * 64; (void)tx; (void)ty;

__global__ void __launch_bounds__(256) k_ada(const float* c, const float* ada_w, const float* ada_b, float* mod) {
    const int j = blockIdx.x * 256 + threadIdx.x, b = blockIdx.y, l = blockIdx.z;
    const float* w = ada_w + (size_t)l * DM * 6 * DM;
    float acc = ada_b[l * 6 * DM + j];
    for (int k = 0; k < DM; ++k) { const float cv = c[b * DM + k]; acc = fmaf(cv / (1.f + expf(-cv)), w[(size_t)k * 6 * DM + j], acc); }
    mod[((size_t)l * NB + b) * 6 * DM + j] = acc;
}
__global__ void __launch_bounds__(256) k_normmod(const float* x, const float* g, const float* sc, const float* sh, bf16* out) {
    const int row = blockIdx.x * 4 + (threadIdx.x >> 6), lane = threadIdx.x & 63, b = row / SEQ;
    const float* xr = x + (size_t)row * DM;
    float v[16]; float s = 0.f;
#pragma unroll
    for (int j = 0; j < 16; ++j) { v[j] = xr[lane + 64 * j]; s += v[j] * v[j]; }
    const float r = rsqrtf(wave_sum(s) * (1.f / DM) + EPS);
#pragma unroll
    for (int j = 0; j < 16; ++j) { const int cidx = lane + 64 * j; out[(size_t)row * DM + cidx] = f2bf(v[j] * r * g[cidx] * (1.f + sc[b * 6 * DM + cidx]) + sh[b * 6 * DM + cidx]); }
}
__global__ void __launch_bounds__(256) k_final(float* x, const float* g) {
    const int row = blockIdx.x * 4 + (threadIdx.x >> 6), lane = threadIdx.x & 63;
    float* xr = x + (size_t)row * DM;
    float v[16]; float s = 0.f;
#pragma unroll
    for (int j = 0; j < 16; ++j) { v[j] = xr[lane + 64 * j]; s += v[j] * v[j]; }
    const float r = rsqrtf(wave_sum(s) * (1.f / DM) + EPS);
#pragma unroll
    for (int j = 0; j < 16; ++j) xr[lane + 64 * j] = v[j] * r * g[lane + 64 * j];
}
__global__ void __launch_bounds__(256) k_zgemm(const bf16* H, const float* w_in, bf16* Z) {
    GEMM_DECL
    gemm_acc(H, DM, w_in, DIN, DM, m0, n0, acc, As, Ws);
    for (int i = 0; i < 4; ++i) for (int j = 0; j < 4; ++j) { const int m = m0 + ty * 4 + i, n = n0 + tx * 4 + j; float v = acc[i][j]; if (n >= 1536) v = gelu_(v); Z[(size_t)m * DIN + n] = f2bf(v); }
}
__global__ void __launch_bounds__(256) k_pool(const bf16* Z, bf16* P) {
    const size_t idx = (size_t)blockIdx.x * 256 + threadIdx.x; const int ch = idx & 511; const int m = (int)(idx >> 9); const int b = m / SEQ, t = m % SEQ;
    const int g = ch >> 7, w = 2 << g; int lo = t - w / 2, hi = t - w / 2 + w; lo = lo < 0 ? 0 : lo; hi = hi > SEQ ? SEQ : hi;
    float s = 0.f; for (int q = lo; q < hi; ++q) s += bf2f(Z[(size_t)(b * SEQ + q) * DIN + ch]);
    P[(size_t)m * WB + ch] = f2bf(s / (float)(hi - lo) - bf2f(Z[(size_t)m * DIN + ch]));
}
__global__ void __launch_bounds__(256) k_poolgemm(const bf16* P, const float* pool_w, const float* pool_s, bf16* YS) {
    GEMM_DECL
    const int g = blockIdx.z;
    gemm_acc(P + g * 128, WB, pool_w + (size_t)g * 128 * 128, 128, 128, m0, n0, acc, As, Ws);
    for (int i = 0; i < 4; ++i) for (int j = 0; j < 4; ++j) { const int m = m0 + ty * 4 + i, n = g * 128 + n0 + tx * 4 + j; YS[(size_t)m * 2048 + n] = f2bf(acc[i][j] * pool_s[n]); }
}
__global__ void __launch_bounds__(64) k_ssm(const bf16* Z, const float* lam_re, const float* lam_im, const float* log_dt, const float* b_re, const float* b_im,
                                            const float* c_re, const float* c_im, const float* d_skip, float* part, bf16* YSSM, int dir) {
    __shared__ float red[16][65];
    const int b = blockIdx.x >> 5, g = blockIdx.x & 31, p = threadIdx.x;
    const float lr = lam_re[(dir * 32 + g) * 64 + p], li = lam_im[(dir * 32 + g) * 64 + p], dt = expf(log_dt[dir * 32 + g]);
    const float mag = expf(lr * dt), are = mag * cosf(li * dt), aim = mag * sinf(li * dt);
    const float den = lr * lr + li * li, nr = are - 1.f, fre = (nr * lr + aim * li) / den, fim = (aim * lr - nr * li) / den;
    float bbr[16], bbi[16], cr[16], ci[16];
#pragma unroll
    for (int h = 0; h < 16; ++h) { const float br = b_re[(g * 64 + p) * 16 + h], bi = b_im[(g * 64 + p) * 16 + h]; bbr[h] = fre * br - fim * bi; bbi[h] = fre * bi + fim * br;
        cr[h] = c_re[((dir * 32 + g) * 16 + h) * 64 + p]; ci[h] = c_im[((dir * 32 + g) * 16 + h) * 64 + p]; }
    float hre = 0.f, him = 0.f;
    const int hh = p & 15, q = p >> 4;
    const float dsk = d_skip[g * 16 + hh];
    for (int step = 0; step < SEQ; ++step) {
        const int t = dir ? SEQ - 1 - step : step; const size_t m = (size_t)b * SEQ + t;
        float u[16]; const bf16* zp = Z + m * DIN + 512 + g * 16;
#pragma unroll
        for (int h = 0; h < 16; ++h) u[h] = bf2f(zp[h]);
        float xre = 0.f, xim = 0.f;
#pragma unroll
        for (int h = 0; h < 16; ++h) { xre = fmaf(bbr[h], u[h], xre); xim = fmaf(bbi[h], u[h], xim); }
        const float nre = are * hre - aim * him + xre, nim = are * him + aim * hre + xim; hre = nre; him = nim;
#pragma unroll
        for (int h = 0; h < 16; ++h) red[h][p] = cr[h] * hre - ci[h] * him;
        __syncthreads();
        float s = 0.f;
#pragma unroll
        for (int k = 0; k < 16; ++k) s += red[hh][q * 16 + k];
        s += __shfl_xor(s, 16); s += __shfl_xor(s, 32);
        __syncthreads();
        if (p < 16) {
            if (dir == 0) part[m * WB + g * 16 + hh] = dsk * bf2f(zp[hh]) + s;
            else YSSM[m * WB + g * 16 + hh] = f2bf(gelu_(part[m * WB + g * 16 + hh] + s));
        }
    }
}
__global__ void __launch_bounds__(256) k_glugemm(const bf16* Y, const float* glu_w, const float* glu_b, bf16* YS) {
    GEMM_DECL
    gemm_acc(Y, WB, glu_w, WB, WB, m0, n0, acc, As, Ws);
    for (int i = 0; i < 4; ++i) for (int j = 0; j < 4; ++j) { const int m = m0 + ty * 4 + i, n = n0 + tx * 4 + j; const float y = bf2f(Y[(size_t)m * WB + n]); YS[(size_t)m * 2048 + 512 + n] = f2bf(y * sigmoidf_(acc[i][j] + glu_b[n])); }
}
__global__ void __launch_bounds__(64) k_lru(const bf16* Z, const float* conv_w, const float* conv_b, const float* wa, const float* ba, const float* wx, const float* bx, const float* lam,
                                            float* part, bf16* YS, int dir) {
    __shared__ float xcs[64];
    const int b = blockIdx.x >> 3, k = blockIdx.x & 7, d = threadIdx.x, ch = k * 64 + d;
    const float cw0 = conv_w[0 * WB + ch], cw1 = conv_w[1 * WB + ch], cw2 = conv_w[2 * WB + ch], cw3 = conv_w[3 * WB + ch], cb = conv_b[ch];
    const float lamv = lam[dir * WB + ch], ls = -log1pf(expf(-lamv));
    const float bav = ba[dir * WB + ch], bxv = bx[dir * WB + ch];
    float war[64], wxr[64];
#pragma unroll
    for (int c = 0; c < 64; ++c) { war[c] = wa[((size_t)(dir * 8 + k) * 64 + c) * 64 + d]; wxr[c] = wx[((size_t)(dir * 8 + k) * 64 + c) * 64 + d]; }
    float h = 0.f;
    for (int step = 0; step < SEQ; ++step) {
        const int t = dir ? SEQ - 1 - step : step; const size_t m = (size_t)b * SEQ + t;
        const bf16* zr = Z + m * DIN + 1024 + ch;
        float xc = cb + cw2 * bf2f(zr[0]);
        if (t >= 2) xc += cw0 * bf2f(zr[-2 * DIN]);
        if (t >= 1) xc += cw1 * bf2f(zr[-1 * DIN]);
        if (t + 1 < SEQ) xc += cw3 * bf2f(zr[DIN]);
        xcs[d] = xc;
        __syncthreads();
        float rp = bav, ip = bxv;
#pragma unroll
        for (int c = 0; c < 64; ++c) { const float xv = xcs[c]; rp = fmaf(xv, war[c], rp); ip = fmaf(xv, wxr[c], ip); }
        __syncthreads();
        const float r = sigmoidf_(rp), ig = sigmoidf_(ip), loga = 8.f * r * ls, a = expf(loga), mult = sqrtf(-expm1f(2.f * loga));
        h = a * h + mult * ig * xc;
        if (dir == 0) part[m * WB + ch] = h;
        else YS[m * 2048 + 1024 + ch] = f2bf((part[m * WB + ch] + h) * bf2f(Z[m * DIN + 1536 + ch]));
    }
}
__global__ void __launch_bounds__(256) k_gmlp_rs(const bf16* Z, float* rs) {
    const int row = blockIdx.x * 4 + (threadIdx.x >> 6), lane = threadIdx.x & 63;
    float s = 0.f;
#pragma unroll
    for (int j = 0; j < 8; ++j) { const float v = bf2f(Z[(size_t)row * DIN + 2560 + lane + 64 * j]); s += v * v; }
    s = wave_sum(s);
    if (lane == 0) rs[row] = rsqrtf(s * (1.f / WB) + EPS);
}
__global__ void __launch_bounds__(256) k_gmlp(const bf16* Z, const float* rs, const float* norm_g, const float* ws, const float* bs, bf16* YS) {
    __shared__ float vn[128][128];
    const int chunk = blockIdx.x, g = blockIdx.y, tok0 = chunk * 128, tid = threadIdx.x;
    for (int e = tid; e < 128 * 128; e += 256) { const int pp = e >> 7, c = e & 127; vn[pp][c] = bf2f(Z[(size_t)(tok0 + pp) * DIN + 2560 + g * 128 + c]) * rs[tok0 + pp] * norm_g[g * 128 + c]; }
    __syncthreads();
    const int c = tid & 127, qh = tid >> 7;
    for (int q = qh * 64; q < qh * 64 + 64; ++q) {
        const float* wrow = ws + ((size_t)g * 128 + q) * 128;
        float acc = 0.f;
        for (int pp = 0; pp < 128; ++pp) acc = fmaf(wrow[pp], vn[pp][c], acc);
        const float sv = acc + bs[g * 128 + q];
        const float u = bf2f(Z[(size_t)(tok0 + q) * DIN + 2048 + g * 128 + c]);
        YS[(size_t)(tok0 + q) * 2048 + 1536 + g * 128 + c] = f2bf(u * sv);
    }
}
__global__ void __launch_bounds__(256) k_merge(const bf16* H, const bf16* YS, const float* w_gate, const float* b_gate, const float* w_branch, bf16* MG) {
    GEMM_DECL
    float mg[4][4]; for (int i = 0; i < 4; ++i) for (int j = 0; j < 4; ++j) mg[i][j] = 0.f;
    for (int k = 0; k < 4; ++k) {
        float accp[4][4];
        for (int i = 0; i < 4; ++i) for (int j = 0; j < 4; ++j) { acc[i][j] = 0.f; accp[i][j] = 0.f; }
        gemm_acc(H, DM, w_gate + k * DM, 4 * DM, DM, m0, n0, acc, As, Ws);
        gemm_acc(YS + k * WB, 2048, w_branch + (size_t)k * WB * DM, DM, WB, m0, n0, accp, As, Ws);
        for (int i = 0; i < 4; ++i) for (int j = 0; j < 4; ++j) { const int n = n0 + tx * 4 + j; mg[i][j] += sigmoidf_(acc[i][j] + b_gate[k * DM + n]) * accp[i][j]; }
    }
    for (int i = 0; i < 4; ++i) for (int j = 0; j < 4; ++j) { const int m = m0 + ty * 4 + i, n = n0 + tx * 4 + j; MG[(size_t)m * DM + n] = f2bf(mg[i][j]); }
}
__global__ void __launch_bounds__(256) k_resgemm(const bf16* A, int K, const float* W, const float* xin, const float* gate, float* xout) {
    GEMM_DECL
    gemm_acc(A, K, W, DM, K, m0, n0, acc, As, Ws);
    for (int i = 0; i < 4; ++i) for (int j = 0; j < 4; ++j) { const int m = m0 + ty * 4 + i, n = n0 + tx * 4 + j, b = m / SEQ; xout[(size_t)m * DM + n] = xin[(size_t)m * DM + n] + gate[b * 6 * DM + n] * acc[i][j]; }
}
__global__ void __launch_bounds__(256) k_ff1(const bf16* H, const float* W, bf16* F1) {
    GEMM_DECL
    gemm_acc(H, DM, W, DFF, DM, m0, n0, acc, As, Ws);
    for (int i = 0; i < 4; ++i) for (int j = 0; j < 4; ++j) { const int m = m0 + ty * 4 + i, n = n0 + tx * 4 + j; const float v = acc[i][j] > 0.f ? acc[i][j] : 0.f; F1[(size_t)m * DFF + n] = f2bf(v * v); }
}
}

extern "C" void kernel_launch(void* const* d_in, const int* in_sizes, int n_in, void* d_out, int out_size, void* d_ws, size_t ws_size, hipStream_t stream) {
    if (n_in != 36 || out_size != M * DM || ws_size < WS_END) { fprintf(stderr, "kernel_launch: unexpected problem (n_in %d out %d ws %zu)\n", n_in, out_size, ws_size); return; }
    const float* const* in = (const float* const*)d_in;
    const float *x = in[0], *c = in[1], *ada_w = in[2], *ada_b = in[3], *norm1_g = in[4], *w_in = in[5], *pool_w = in[6], *pool_s = in[7];
    const float *lam_re = in[8], *lam_im = in[9], *log_dt = in[10], *b_re = in[11], *b_im = in[12], *c_re = in[13], *c_im = in[14], *ssm_d = in[15], *glu_w = in[16], *glu_b = in[17];
    const float *conv_w = in[18], *conv_b = in[19], *lru_wa = in[20], *lru_ba = in[21], *lru_wx = in[22], *lru_bx = in[23], *lru_lam = in[24];
    const float *gm_g = in[25], *gm_ws = in[26], *gm_bs = in[27], *w_branch = in[28], *w_gate = in[29], *b_gate = in[30], *w_out = in[31], *norm2_g = in[32], *w_ff1 = in[33], *w_ff2 = in[34], *final_g = in[35];
    char* ws = (char*)d_ws; float* X = (float*)d_out;
    float* MOD = (float*)(ws + WS_MOD); float* RS = (float*)(ws + WS_RS);
    bf16 *H = (bf16*)(ws + WS_H), *Z = (bf16*)(ws + WS_Z), *YS = (bf16*)(ws + WS_YS), *YSSM = (bf16*)(ws + WS_YSSM), *MG = (bf16*)(ws + WS_MERGED), *F1 = (bf16*)(ws + WS_F1);
    float* PART = (float*)(ws + WS_MERGED);
    k_ada<<<dim3(6 * DM / 256, NB, DEPTH), 256, 0, stream>>>(c, ada_w, ada_b, MOD);
    for (int l = 0; l < DEPTH; ++l) {
        const float* mod = MOD + (size_t)l * NB * 6 * DM;
        const float* xin = l == 0 ? x : X;
        k_normmod<<<M / 4, 256, 0, stream>>>(xin, norm1_g + l * DM, mod + 1 * DM, mod + 0 * DM, H);
        k_zgemm<<<dim3(DIN / 64, M / 64), 256, 0, stream>>>(H, w_in + (size_t)l * DM * DIN, Z);
        k_pool<<<(M * WB) / 256, 256, 0, stream>>>(Z, YSSM);
        k_poolgemm<<<dim3(2, M / 64, 4), 256, 0, stream>>>(YSSM, pool_w + (size_t)l * 4 * 128 * 128, pool_s + l * WB, YS);
        for (int dir = 0; dir < 2; ++dir)
            k_ssm<<<NB * 32, 64, 0, stream>>>(Z, lam_re + l * 2 * 32 * 64, lam_im + l * 2 * 32 * 64, log_dt + l * 2 * 32, b_re + (size_t)l * 32 * 64 * 16, b_im + (size_t)l * 32 * 64 * 16,
                                              c_re + (size_t)l * 2 * 32 * 16 * 64, c_im + (size_t)l * 2 * 32 * 16 * 64, ssm_d + l * WB, PART, YSSM, dir);
        k_glugemm<<<dim3(WB / 64, M / 64), 256, 0, stream>>>(YSSM, glu_w + (size_t)l * WB * WB, glu_b + l * WB, YS);
        for (int dir = 0; dir < 2; ++dir)
            k_lru<<<NB * 8, 64, 0, stream>>>(Z, conv_w + l * 4 * WB, conv_b + l * WB, lru_wa + (size_t)l * 2 * 8 * 64 * 64, lru_ba + l * 2 * WB, lru_wx + (size_t)l * 2 * 8 * 64 * 64, lru_bx + l * 2 * WB,
                                             lru_lam + l * 2 * WB, PART, YS, dir);
        k_gmlp_rs<<<M / 4, 256, 0, stream>>>(Z, RS);
        k_gmlp<<<dim3(M / 128, 4), 256, 0, stream>>>(Z, RS, gm_g + l * WB, gm_ws + (size_t)l * 4 * 128 * 128, gm_bs + l * 4 * 128, YS);
        k_merge<<<dim3(DM / 64, M / 64), 256, 0, stream>>>(H, YS, w_gate + (size_t)l * DM * 4 * DM, b_gate + l * 4 * DM, w_branch + (size_t)l * 4 * WB * DM, MG);
        k_resgemm<<<dim3(DM / 64, M / 64), 256, 0, stream>>>(MG, DM, w_out + (size_t)l * DM * DM, xin, mod + 2 * DM, X);
        k_normmod<<<M / 4, 256, 0, stream>>>(X, norm2_g + l * DM, mod + 4 * DM, mod + 3 * DM, H);
        k_ff1<<<dim3(DFF / 64, M / 64), 256, 0, stream>>>(H, w_ff1 + (size_t)l * DM * DFF, F1);
        k_resgemm<<<dim3(DM / 64, M / 64), 256, 0, stream>>>(F1, DFF, w_ff2 + (size_t)l * DFF * DM, X, mod + 5 * DM, X);
    }
    k_final<<<M / 4, 256, 0, stream>>>(X, final_g);
}
```

```cpp
#include <hip/hip_runtime.h>
#include <stdint.h>
#include <stdio.h>
namespace pg8 {
#define PG8_LAS __attribute__((address_space(3)))
typedef unsigned short bf16_t;
typedef short bf16x8 __attribute__((ext_vector_type(8)));
typedef float f32x4 __attribute__((ext_vector_type(4)));
typedef unsigned u32x4 __attribute__((ext_vector_type(4)));
constexpr int BM = 256, BK = 64, HALF = 128, HTB = HALF * BK * 2  , STAGE_BYTES = 8 * HTB, NXCD = 8, WGM = 8;

__host__ __device__ __forceinline__ int lds_byte(int r, int c) { const int st = (r >> 4) * 2 + (c >> 5), rr = r & 15, cc = c & 31, ob = rr * 64 + cc * 2; return st * 1024 + (ob ^ (((ob >> 9) & 1) << 5)); }
__host__ __device__ __forceinline__ void stage_rc(int b, int& R, int& C) { const int st = b / 1024, sb = b % 1024, swz = sb ^ (((sb >> 9) & 1) << 5); R = (st >> 1) * 16 + swz / 64; C = (st & 1) * 32 + (swz % 64) / 2; }
__host__ __device__ __forceinline__ int perm32(int rho) { const int n = rho >> 4, i = rho & 15; return 8 * (i >> 2) + 4 * n + (i & 3); }

struct Unit { int pm, pn; };
struct Gemm { const bf16_t* A; const bf16_t* Bt; int M, N, K; };

struct StaticOrder {
    int nM, nN, nwg, G, c;
    __host__ __device__ void init(int M, int N, int G_, int c_) { nM = M / BM; nN = N / BM; nwg = nM * nN; G = G_; c = c_; }
    __host__ __device__ bool next(int i, Unit& u) const {
        const long L = (long)i * G + c; if (L >= nwg) return false;
        int wgid = (int)L; { const int q = nwg / NXCD, r = nwg % NXCD, xcd = wgid % NXCD, off = wgid / NXCD; wgid = (xcd < r ? xcd * (q + 1) : r * (q + 1) + (xcd - r) * q) + off; }
        const int nig = WGM * nN, gid = wgid / nig, fm = gid * WGM, gsz = (nM - fm) < WGM ? (nM - fm) : WGM;
        u.pm = fm + ((wgid % nig) % gsz); u.pn = (wgid % nig) / gsz; return true;
    }
    __device__ __forceinline__ void a_ready(const Unit&) const {}
    __device__ __forceinline__ void done(const Unit&) const {}
};

__device__ __forceinline__ unsigned cvt_pk_bf16(float lo, float hi) { unsigned r; asm volatile("v_cvt_pk_bf16_f32 %0, %1, %2" : "=v"(r) : "v"(lo), "v"(hi)); return r; }
__device__ __forceinline__ float fast_sigmoid(float x) { return __builtin_amdgcn_rcpf(1.0f + __builtin_amdgcn_exp2f(-1.4426950408889634f * x)); }
__device__ __forceinline__ float gelu_tanh(float x) { const float u = x * (0.7978845608028654f + 0.0356774081363001f * x * x); return x * __builtin_amdgcn_rcpf(1.0f + __builtin_amdgcn_exp2f(-2.885390081777927f * u)); }
__device__ __forceinline__ float bf_lo(unsigned w) { return __builtin_bit_cast(float, w << 16); }
__device__ __forceinline__ float bf_hi(unsigned w) { return __builtin_bit_cast(float, w & 0xffff0000u); }

template <int ACT> struct EpiBf16x {
    static constexpr bool PERM = true, AFTER_DRAIN = false, HAS_MID = false;
    bf16_t *O0, *O1, *O2; int ldc; int split_cols; int gelu_from;
    __device__ __forceinline__ void operator()(const f32x4 (&acc)[2][2][4][2], const Unit& u, int wr, int wc, int fr, int fq) const {
        const int row0 = u.pm * BM + wr * 64 + fr; int colt = u.pn * BM; bf16_t* base = O0;
        const bool act1 = (ACT == 1) && (colt >= gelu_from);
        if (split_cols) { const int t = colt / split_cols; base = t == 0 ? O0 : (t == 1 ? O1 : O2); colt -= t * split_cols; }
        const int col0 = colt + wc * 32 + 8 * fq;
#pragma unroll
        for (int ai = 0; ai < 2; ++ai)
#pragma unroll
            for (int m = 0; m < 4; ++m) { bf16_t* rowp = base + (size_t)(row0 + ai * HALF + m * 16) * ldc + col0;
#pragma unroll
                for (int bj = 0; bj < 2; ++bj) { f32x4 v0 = acc[ai][bj][m][0], v1 = acc[ai][bj][m][1];
                    if (ACT == 1) { if (act1) {
#pragma unroll
                        for (int j = 0; j < 4; ++j) { v0[j] = gelu_tanh(v0[j]); v1[j] = gelu_tanh(v1[j]); } } }
                    if (ACT == 2) {
#pragma unroll
                        for (int j = 0; j < 4; ++j) { const float a = fmaxf(v0[j], 0.f), b = fmaxf(v1[j], 0.f); v0[j] = a * a; v1[j] = b * b; } }
                    u32x4 w; w.x = cvt_pk_bf16(v0[0], v0[1]); w.y = cvt_pk_bf16(v0[2], v0[3]); w.z = cvt_pk_bf16(v1[0], v1[1]); w.w = cvt_pk_bf16(v1[2], v1[3]);
                    *(u32x4*)(rowp + bj * HALF) = w; } }
    }
};
struct EpiGlu {
    static constexpr bool PERM = true, AFTER_DRAIN = false, HAS_MID = false;
    const bf16_t* Y; int ldy; bf16_t* O; int ldo; int ocol; const float* bias;
    __device__ __forceinline__ void operator()(const f32x4 (&acc)[2][2][4][2], const Unit& u, int wr, int wc, int fr, int fq) const {
        const int row0 = u.pm * BM + wr * 64 + fr, col0 = u.pn * BM + wc * 32 + 8 * fq;
        f32x4 bv[2][2];
#pragma unroll
        for (int bj = 0; bj < 2; ++bj)
#pragma unroll
            for (int n = 0; n < 2; ++n) bv[bj][n] = *(const f32x4*)(bias + col0 + bj * HALF + 4 * n);
#pragma unroll
        for (int ai = 0; ai < 2; ++ai)
#pragma unroll
            for (int m = 0; m < 4; ++m) { const size_t r = (size_t)(row0 + ai * HALF + m * 16);
#pragma unroll
                for (int bj = 0; bj < 2; ++bj) { const u32x4 yv = *(const u32x4*)(Y + r * ldy + col0 + bj * HALF);
                    const f32x4 a0 = acc[ai][bj][m][0] + bv[bj][0], a1 = acc[ai][bj][m][1] + bv[bj][1];
                    u32x4 w;
                    w.x = cvt_pk_bf16(bf_lo(yv.x) * fast_sigmoid(a0[0]), bf_hi(yv.x) * fast_sigmoid(a0[1]));
                    w.y = cvt_pk_bf16(bf_lo(yv.y) * fast_sigmoid(a0[2]), bf_hi(yv.y) * fast_sigmoid(a0[3]));
                    w.z = cvt_pk_bf16(bf_lo(yv.z) * fast_sigmoid(a1[0]), bf_hi(yv.z) * fast_sigmoid(a1[1]));
                    w.w = cvt_pk_bf16(bf_lo(yv.w) * fast_sigmoid(a1[2]), bf_hi(yv.w) * fast_sigmoid(a1[3]));
                    *(u32x4*)(O + r * ldo + ocol + col0 + bj * HALF) = w; } }
    }
};
typedef unsigned u32x2 __attribute__((ext_vector_type(2)));
__device__ __forceinline__ unsigned gate_q(float x) { float q = 255.0f * fast_sigmoid(x) + 0.5f; q = fminf(fmaxf(q, 1.0f), 255.0f); return (unsigned)q; }
struct EpiGate {
    static constexpr bool PERM = true, AFTER_DRAIN = false, HAS_MID = false;
    unsigned char* G; int ntn; const float* bias;
    __device__ __forceinline__ void operator()(const f32x4 (&acc)[2][2][4][2], const Unit& u, int wr, int wc, int fr, int fq) const {
        const int wid = wr * 4 + wc, lane = fq * 16 + fr, col0 = u.pn * BM + wc * 32 + 8 * fq;
        unsigned char* tile = G + ((size_t)u.pm * ntn + u.pn) * 65536 + (size_t)wid * 16 * 512 + lane * 8;
        f32x4 bv[2][2];
#pragma unroll
        for (int bj = 0; bj < 2; ++bj)
#pragma unroll
            for (int n = 0; n < 2; ++n) bv[bj][n] = *(const f32x4*)(bias + col0 + bj * HALF + 4 * n);
#pragma unroll
        for (int ai = 0; ai < 2; ++ai)
#pragma unroll
            for (int m = 0; m < 4; ++m)
#pragma unroll
                for (int bj = 0; bj < 2; ++bj) { const f32x4 a0 = acc[ai][bj][m][0] + bv[bj][0], a1 = acc[ai][bj][m][1] + bv[bj][1];
                    u32x2 w;
                    w.x = gate_q(a0[0]) | (gate_q(a0[1]) << 8) | (gate_q(a0[2]) << 16) | (gate_q(a0[3]) << 24);
                    w.y = gate_q(a1[0]) | (gate_q(a1[1]) << 8) | (gate_q(a1[2]) << 16) | (gate_q(a1[3]) << 24);
                    *(u32x2*)(tile + ((ai * 4 + m) * 2 + bj) * 512) = w; }
    }
};
struct EpiBranch {
    static constexpr bool PERM = true, AFTER_DRAIN = false, HAS_MID = true;
    const unsigned char* G; bf16_t* O; int ldc;
    __device__ __forceinline__ void mid(f32x4 (&acc)[2][2][4][2], const Unit& u, int s, int wid, int lane) const {
        const unsigned char* ta = G + ((size_t)u.pm * 16 + 4 * (s - 1) + u.pn) * 65536 + (size_t)wid * 16 * 512 + lane * 8;
        const unsigned char* tb = ta + (size_t)4 * 65536;
#pragma unroll
        for (int ai = 0; ai < 2; ++ai)
#pragma unroll
            for (int m = 0; m < 4; ++m)
#pragma unroll
                for (int bj = 0; bj < 2; ++bj) { const int o = ((ai * 4 + m) * 2 + bj) * 512; const u32x2 a = *(const u32x2*)(ta + o), b = *(const u32x2*)(tb + o);
#pragma unroll
                    for (int j = 0; j < 4; ++j) {
                        acc[ai][bj][m][0][j] *= (float)((a.x >> (8 * j)) & 255u) * __builtin_amdgcn_rcpf((float)((b.x >> (8 * j)) & 255u));
                        acc[ai][bj][m][1][j] *= (float)((a.y >> (8 * j)) & 255u) * __builtin_amdgcn_rcpf((float)((b.y >> (8 * j)) & 255u)); } }
    }
    __device__ __forceinline__ void operator()(const f32x4 (&acc)[2][2][4][2], const Unit& u, int wr, int wc, int fr, int fq) const {
        const int wid = wr * 4 + wc, lane = fq * 16 + fr;
        const unsigned char* ta = G + ((size_t)u.pm * 16 + 12 + u.pn) * 65536 + (size_t)wid * 16 * 512 + lane * 8;
        const int row0 = u.pm * BM + wr * 64 + fr, col0 = u.pn * BM + wc * 32 + 8 * fq;
#pragma unroll
        for (int ai = 0; ai < 2; ++ai)
#pragma unroll
            for (int m = 0; m < 4; ++m) { bf16_t* rowp = O + (size_t)(row0 + ai * HALF + m * 16) * ldc + col0;
#pragma unroll
                for (int bj = 0; bj < 2; ++bj) { const u32x2 a = *(const u32x2*)(ta + ((ai * 4 + m) * 2 + bj) * 512); f32x4 v0 = acc[ai][bj][m][0], v1 = acc[ai][bj][m][1];
#pragma unroll
                    for (int j = 0; j < 4; ++j) { v0[j] *= (float)((a.x >> (8 * j)) & 255u) * (1.0f / 255.0f); v1[j] *= (float)((a.y >> (8 * j)) & 255u) * (1.0f / 255.0f); }
                    u32x4 w; w.x = cvt_pk_bf16(v0[0], v0[1]); w.y = cvt_pk_bf16(v0[2], v0[3]); w.z = cvt_pk_bf16(v1[0], v1[1]); w.w = cvt_pk_bf16(v1[2], v1[3]);
                    *(u32x4*)(rowp + bj * HALF) = w; } }
    }
};
struct EpiRes {
    static constexpr bool PERM = false, AFTER_DRAIN = false, HAS_MID = false;
    const float* xin; float* xout; int ldc; const float* gate; int gld; int tiles_per_batch;
    __device__ __forceinline__ void operator()(const f32x4 (&acc)[2][2][4][2], const Unit& u, int wr, int wc, int fr, int fq) const {
        const int row0 = u.pm * BM + wr * 64 + fr, col0 = u.pn * BM + wc * 32 + 4 * fq;
        const float* gp = gate + (size_t)(u.pm / tiles_per_batch) * gld + col0;
        f32x4 gv[2][2];
#pragma unroll
        for (int bj = 0; bj < 2; ++bj)
#pragma unroll
            for (int n = 0; n < 2; ++n) gv[bj][n] = *(const f32x4*)(gp + bj * HALF + n * 16);
#pragma unroll
        for (int ai = 0; ai < 2; ++ai)
#pragma unroll
            for (int m = 0; m < 4; ++m) { const size_t off = (size_t)(row0 + ai * HALF + m * 16) * ldc + col0;
#pragma unroll
                for (int bj = 0; bj < 2; ++bj)
#pragma unroll
                    for (int n = 0; n < 2; ++n) { const f32x4 xi = *(const f32x4*)(xin + off + bj * HALF + n * 16); *(f32x4*)(xout + off + bj * HALF + n * 16) = xi + gv[bj][n] * acc[ai][bj][m][n]; } }
    }
};
template <class Epi, class Sched, bool ALIGN_EPI = false, bool SP2 = false>
__device__ __forceinline__ void gemm_phase(PG8_LAS unsigned char* lds, const Gemm g, const Sched& S, const Epi& E) {
    int tid_ = threadIdx.x; asm volatile("" : "+v"(tid_)); const int tid = tid_, wid = __builtin_amdgcn_readfirstlane(tid >> 6), lane = tid & 63, wr = wid >> 2, wc = wid & 3, fr = lane & 15, fq = lane >> 4;
    const int K = g.K, nt = K / BK;
    unsigned voffA[2], voffB[2];
#pragma unroll
    for (int i = 0; i < 2; ++i) { int R, C; stage_rc(tid * 16 + i * 8192, R, C); const int Rb = Epi::PERM ? ((R & ~31) + perm32(R & 31)) : R;
        voffA[i] = (unsigned)(R * K + C) * 2u; voffB[i] = (unsigned)(Rb * K + C) * 2u; }
    const size_t kstep = (size_t)(BK * 2);
    const size_t hstep = (size_t)HALF * K * 2;
    const size_t tstep = 2 * hstep;
    const unsigned ldsw = (unsigned)wid * 1024u;
    const int aoff = lds_byte(wr * 64 + fr, fq * 8), boff = lds_byte(wc * 32 + fr, fq * 8);
#define PG8_SA(b, h) (((b) * 2 + (h)) * HTB)
#define PG8_SB(b, h) ((4 + (b) * 2 + (h)) * HTB)
#define PG8_STAGE(bufoff, gbase, voff) do { _Pragma("unroll") for (int _i = 0; _i < 2; ++_i) \
        __builtin_amdgcn_global_load_lds((const unsigned*)((const char*)(gbase) + (voff)[_i]), (PG8_LAS unsigned*)(lds + (bufoff) + ldsw + _i * 8192), 16, 0, 0); } while (0)
#define PG8_LDA(dst, b, h) do { _Pragma("unroll") for (int m = 0; m < 4; ++m) _Pragma("unroll") for (int k = 0; k < 2; ++k) dst[m][k] = *(const PG8_LAS bf16x8*)(lds + PG8_SA(b, h) + aoff + m * 2048 + k * 1024); } while (0)
#define PG8_LDB(dst, b, h) do { _Pragma("unroll") for (int n = 0; n < 2; ++n) _Pragma("unroll") for (int k = 0; k < 2; ++k) dst[n][k] = *(const PG8_LAS bf16x8*)(lds + PG8_SB(b, h) + boff + n * 2048 + k * 1024); } while (0)
#define PG8_MMA(ai, bj, At, Bt) do { __builtin_amdgcn_s_setprio(1); _Pragma("unroll") for (int m = 0; m < 4; ++m) _Pragma("unroll") for (int n = 0; n < 2; ++n) _Pragma("unroll") for (int k = 0; k < 2; ++k) \
        acc[ai][bj][m][n] = __builtin_amdgcn_mfma_f32_16x16x32_bf16(Bt[n][k], At[m][k], acc[ai][bj][m][n], 0, 0, 0); __builtin_amdgcn_s_setprio(0); } while (0)
#define PG8_WAIT_V(n) asm volatile("s_waitcnt vmcnt(" #n ")" ::: "memory")
#define PG8_WAIT_L(n) asm volatile("s_waitcnt lgkmcnt(" #n ")" ::: "memory")
#define PG8_BAR __builtin_amdgcn_s_barrier()
#define PG8_SCHED __builtin_amdgcn_sched_barrier(0)
    Unit cur, nxt; int ui = 0;
    if (!S.next(0, cur)) return;
    f32x4 acc[2][2][4][2];
#pragma unroll
    for (int a = 0; a < 2; ++a)
#pragma unroll
        for (int b = 0; b < 2; ++b)
#pragma unroll
            for (int m = 0; m < 4; ++m)
#pragma unroll
                for (int n = 0; n < 2; ++n) acc[a][b][m][n] = (f32x4){0.f, 0.f, 0.f, 0.f};
    bf16x8 At[4][2], B0[2][2], B1[2][2];
    const char* cA = (const char*)g.A + (size_t)cur.pm * tstep; const char* cB = (const char*)g.Bt + (size_t)cur.pn * tstep;
    S.a_ready(cur);
    if constexpr (SP2) {
        PG8_STAGE(PG8_SB(0, 0), cB, voffB); PG8_STAGE(PG8_SB(0, 1), cB + hstep, voffB); PG8_STAGE(PG8_SA(0, 0), cA, voffA); PG8_STAGE(PG8_SA(0, 1), cA + hstep, voffA);
        if (wr == 1) PG8_BAR;
        PG8_WAIT_V(2); PG8_BAR;
        PG8_STAGE(PG8_SB(1, 0), cB + kstep, voffB); PG8_STAGE(PG8_SA(1, 0), cA + kstep, voffA); PG8_STAGE(PG8_SB(1, 1), cB + hstep + kstep, voffB);
        PG8_WAIT_V(6); PG8_BAR;
    } else {
        PG8_STAGE(PG8_SB(0, 0), cB, voffB); PG8_STAGE(PG8_SA(0, 0), cA, voffA); PG8_STAGE(PG8_SB(0, 1), cB + hstep, voffB); PG8_STAGE(PG8_SA(0, 1), cA + hstep, voffA);
        if (wr == 1) PG8_BAR;
        PG8_WAIT_V(4); PG8_BAR;
        PG8_STAGE(PG8_SB(1, 0), cB + kstep, voffB); PG8_STAGE(PG8_SA(1, 0), cA + kstep, voffA); PG8_STAGE(PG8_SB(1, 1), cB + hstep + kstep, voffB);
        PG8_WAIT_V(6); PG8_BAR;
    }
    for (;;) {
        const bool has_next = S.next(ui + 1, nxt);
        const char* nA = has_next ? (const char*)g.A + (size_t)nxt.pm * tstep : cA; const char* nB = has_next ? (const char*)g.Bt + (size_t)nxt.pn * tstep : cB;
        for (int t = 0; t < nt; t += 2) {
            const bool last = (t == nt - 2);
            if constexpr (Epi::HAS_MID) { if (t != 0 && (t & 7) == 0) E.mid(acc, cur, t >> 3, wid, lane); }
            const char* a1 = cA + (size_t)(t + 1) * kstep;
            const char* a2 = last ? nA : cA + (size_t)(t + 2) * kstep; const char* b2 = last ? nB : cB + (size_t)(t + 2) * kstep;
            const char* a3 = a2 + kstep; const char* b3 = b2 + kstep;
            if (last && has_next) S.a_ready(nxt);
            if constexpr (SP2) {
            PG8_LDB(B0, 0, 0); PG8_LDB(B1, 0, 1); PG8_SCHED; PG8_LDA(At, 0, 0); PG8_STAGE(PG8_SA(1, 1), a1 + hstep, voffA);
            PG8_WAIT_V(8); PG8_WAIT_L(0); PG8_BAR; PG8_MMA(0, 0, At, B0); PG8_MMA(0, 1, At, B1); PG8_BAR; PG8_SCHED;
            PG8_LDA(At, 0, 1); PG8_STAGE(PG8_SB(0, 0), b2, voffB); PG8_STAGE(PG8_SB(0, 1), b2 + hstep, voffB); PG8_STAGE(PG8_SA(0, 0), a2, voffA);
            PG8_WAIT_V(8); PG8_WAIT_L(0); PG8_BAR; PG8_MMA(1, 0, At, B0); PG8_MMA(1, 1, At, B1); PG8_BAR; PG8_SCHED;
            PG8_LDB(B0, 1, 0); PG8_LDB(B1, 1, 1); PG8_SCHED; PG8_LDA(At, 1, 0); PG8_STAGE(PG8_SA(0, 1), a2 + hstep, voffA);
            PG8_WAIT_V(8); PG8_WAIT_L(0); PG8_BAR; PG8_MMA(0, 0, At, B0); PG8_MMA(0, 1, At, B1); PG8_BAR; PG8_SCHED;
            PG8_LDA(At, 1, 1); PG8_STAGE(PG8_SB(1, 0), b3, voffB); PG8_STAGE(PG8_SB(1, 1), b3 + hstep, voffB); PG8_STAGE(PG8_SA(1, 0), a3, voffA);
            PG8_WAIT_V(8); PG8_WAIT_L(0); PG8_BAR; PG8_MMA(1, 0, At, B0); PG8_MMA(1, 1, At, B1); PG8_BAR; PG8_SCHED;
            } else {
            PG8_LDB(B0, 0, 0); PG8_SCHED; PG8_LDA(At, 0, 0); PG8_STAGE(PG8_SA(1, 1), a1 + hstep, voffA);
            PG8_WAIT_L(8); PG8_BAR; PG8_WAIT_L(0); PG8_MMA(0, 0, At, B0); PG8_BAR; PG8_SCHED;
            PG8_LDB(B1, 0, 1); PG8_STAGE(PG8_SB(0, 0), b2, voffB);
            PG8_BAR; PG8_WAIT_L(0); PG8_MMA(0, 1, At, B1); PG8_BAR;
            PG8_LDA(At, 0, 1); PG8_STAGE(PG8_SA(0, 0), a2, voffA);
            PG8_BAR; PG8_WAIT_L(0); PG8_MMA(1, 0, At, B0); PG8_BAR; PG8_SCHED;
            PG8_STAGE(PG8_SB(0, 1), b2 + hstep, voffB);
            PG8_WAIT_V(6); PG8_BAR; PG8_MMA(1, 1, At, B1); PG8_BAR;
            PG8_LDB(B0, 1, 0); PG8_SCHED; PG8_LDA(At, 1, 0); PG8_STAGE(PG8_SA(0, 1), a2 + hstep, voffA);
            PG8_WAIT_L(8); PG8_BAR; PG8_WAIT_L(0); PG8_MMA(0, 0, At, B0); PG8_BAR; PG8_SCHED;
            PG8_LDB(B1, 1, 1); PG8_STAGE(PG8_SB(1, 0), b3, voffB);
            PG8_BAR; PG8_WAIT_L(0); PG8_MMA(0, 1, At, B1); PG8_BAR;
            PG8_LDA(At, 1, 1); PG8_STAGE(PG8_SA(1, 0), a3, voffA);
            PG8_BAR; PG8_WAIT_L(0); PG8_MMA(1, 0, At, B0); PG8_BAR; PG8_SCHED;
            PG8_STAGE(PG8_SB(1, 1), b3 + hstep, voffB);
            PG8_WAIT_V(6); PG8_BAR; PG8_MMA(1, 1, At, B1); PG8_BAR;
            }
        }
        if constexpr (ALIGN_EPI) { if (wr == 0) PG8_BAR; }
        if constexpr (!Epi::AFTER_DRAIN) { E(acc, cur, wr, wc, fr, fq); S.done(cur); }
        if (!has_next) break;
#pragma unroll
        for (int a = 0; a < 2; ++a)
#pragma unroll
            for (int b = 0; b < 2; ++b)
#pragma unroll
                for (int m = 0; m < 4; ++m)
#pragma unroll
                    for (int n = 0; n < 2; ++n) acc[a][b][m][n] = (f32x4){0.f, 0.f, 0.f, 0.f};
        cur = nxt; cA = nA; cB = nB; ++ui;
        if constexpr (ALIGN_EPI) { if (wr == 1) PG8_BAR; }
    }
    PG8_WAIT_V(0);
    if constexpr (!ALIGN_EPI) { if (wr == 0) PG8_BAR; }
    PG8_BAR;
    if constexpr (Epi::AFTER_DRAIN) { E.fused(acc, cur, wr, wc, fr, fq, lds, wid, lane); S.done(cur); }
#undef PG8_SA
#undef PG8_SB
#undef PG8_STAGE
#undef PG8_LDA
#undef PG8_LDB
#undef PG8_MMA
#undef PG8_WAIT_V
#undef PG8_WAIT_L
#undef PG8_BAR
#undef PG8_SCHED
}
}

#ifndef PG8_SP2
#define PG8_SP2 true
#endif
#ifndef PG8_ALIGN
#define PG8_ALIGN true
#endif
constexpr int NWAVES = 8;
constexpr int DM = 1024, NB = 8, SEQ = 2048, M = NB * SEQ, DEPTH = 2;
constexpr int DIN = 3072, DFF = 4096, WB = 512, NGATE = 4096;
constexpr float EPS = 1e-6f;
typedef unsigned short bf16;
constexpr size_t MiB = 1u << 20;
constexpr size_t WS_CTL = 0, CTL_ZERO_BYTES = 1 * MiB;
constexpr size_t WS_MOD = 1 * MiB;
constexpr size_t WS_RS = 1 * MiB + 512 * 1024;
constexpr size_t WS_WIN = 2 * MiB, WS_WG = 8 * MiB, WS_WB = 16 * MiB, WS_WO = 20 * MiB, WS_W1 = 22 * MiB, WS_W2 = 30 * MiB, WS_WGLU = 38 * MiB;
constexpr size_t WS_H = 40 * MiB;
constexpr size_t WS_ZA = 72 * MiB, WS_ZC = 104 * MiB, WS_ZB = 136 * MiB;
constexpr size_t WS_GATES = 72 * MiB;
constexpr size_t WS_MERGED = 136 * MiB;
constexpr size_t WS_YS = 168 * MiB;
constexpr size_t WS_YSSM = 232 * MiB;
constexpr size_t WS_F1 = 72 * MiB;
constexpr size_t WS_END = 248 * MiB;
constexpr int CW_BAR = 4096;
constexpr int RING_OFF = 0, RING_BYTES = 131072;
constexpr int LDSCTL_OFF = RING_BYTES, MISC_OFF = LDSCTL_OFF + 320;
constexpr int LDS_BYTES = 147456;
#define GAS __attribute__((address_space(1)))
#define LAS __attribute__((address_space(3)))
typedef unsigned v4u __attribute__((ext_vector_type(4)));
typedef float f32x4 __attribute__((ext_vector_type(4)));
typedef GAS unsigned gu32;
#define LDS_WAIT() asm volatile("s_waitcnt lgkmcnt(0)" ::: "memory")
#define VM_WAIT() asm volatile("s_waitcnt vmcnt(0)" ::: "memory")
__device__ __forceinline__ unsigned f2bf(float f) { unsigned u = __builtin_bit_cast(unsigned, f); return (u + 0x7fffu + ((u >> 16) & 1u)) >> 16; }
__device__ __forceinline__ unsigned pk2(float lo, float hi) { return f2bf(lo) | (f2bf(hi) << 16); }
__device__ __forceinline__ float bf2f(bf16 h) { return __builtin_bit_cast(float, (unsigned)h << 16); }
#define XB_TMO      128
#define XB_XCNT(j)  (256  + 64 * (j))
#define XB_XSUB(j)  (1280 + 64 * (j))
#define XB_XGEN(j)  (2304 + 64 * (j))
#define XB_TOP      3328
#define XB_TOPGEN   3392
#define XCD_BAR_WORDS 3456
#define XB_SPIN_CAP (1u << 18)

__device__ __forceinline__ unsigned xb_ld(unsigned* p)              { return __hip_atomic_load(p, __ATOMIC_RELAXED, __HIP_MEMORY_SCOPE_AGENT); }
__device__ __forceinline__ unsigned xb_add(unsigned* p, unsigned v) { return __hip_atomic_fetch_add(p, v, __ATOMIC_RELAXED, __HIP_MEMORY_SCOPE_AGENT); }
__device__ __forceinline__ unsigned xb_xcc_id() { return (unsigned)__builtin_amdgcn_s_getreg((3 << 11) | 20) & 0xFu; }
#define XB_SPIN(cond, bar) do { unsigned _sp = 0; while (cond) { __builtin_amdgcn_s_sleep(1); \
    if ((++_sp & 255u) == 0u) { if (xb_ld(&(bar)[XB_TMO])) break; if (_sp > XB_SPIN_CAP) { atomicAdd(&(bar)[XB_TMO], 1u); break; } } } } while (0)

struct XcdBarrier {
    unsigned* bar; unsigned x;
    volatile LAS unsigned* st;
};

__device__ __forceinline__ XcdBarrier xcd_barrier_post(unsigned* bar, volatile LAS unsigned* st) {
    XcdBarrier b; b.bar = bar; b.x = xb_xcc_id(); b.st = st;
    if (threadIdx.x == 0) (void)xb_add(&bar[XB_XCNT(b.x)], 1u);
    return b;
}
__device__ __forceinline__ void xcd_barrier_complete(unsigned* bar, unsigned x, unsigned& nloc, unsigned& nx) {
    const unsigned G = gridDim.x * gridDim.y * gridDim.z;
    unsigned sum, cnt, mine, sp = 0u;
    for (;;) {
        sum = 0u; cnt = 0u; mine = 0u;
#pragma unroll
        for (unsigned j = 0; j < 16; ++j) { const unsigned c = xb_ld(&bar[XB_XCNT(j)]); sum += c; cnt += (c > 0u) ? 1u : 0u; mine = (j == x) ? c : mine; }
        if (sum == G) break;
        __builtin_amdgcn_s_sleep(1);
        if ((++sp & 255u) == 0u) { if (xb_ld(&bar[XB_TMO])) break; if (sp > XB_SPIN_CAP) { atomicAdd(&bar[XB_TMO], 1u); break; } }
    }
    nloc = mine > 0u ? mine : 1u; nx = cnt > 0u ? cnt : 1u;
}

__device__ __forceinline__ void xcd_barrier(const XcdBarrier& b) {
    asm volatile("s_waitcnt vmcnt(0)" ::: "memory");
    __syncthreads();
    if (threadIdx.x == 0) {
        unsigned* bar = b.bar;
        __builtin_amdgcn_s_waitcnt(0);
        unsigned nloc = b.st[0], nx = b.st[1];
        if (nloc == 0u) { xcd_barrier_complete(bar, b.x, nloc, nx); b.st[0] = nloc; b.st[1] = nx; }
        const unsigned old = xb_add(&bar[XB_XSUB(b.x)], 1u);
        const unsigned gen = old / nloc;
        if (old + 1u == (gen + 1u) * nloc) {
            __builtin_amdgcn_fence(__ATOMIC_RELEASE, "agent");
            asm volatile("s_waitcnt vmcnt(0)" ::: "memory");
            const unsigned og = xb_add(&bar[XB_TOP], 1u);
            const unsigned tg = og / nx;
            if (og + 1u == (tg + 1u) * nx) xb_add(&bar[XB_TOPGEN], 1u);
            else XB_SPIN(xb_ld(&bar[XB_TOPGEN]) == tg, bar);
            __builtin_amdgcn_fence(__ATOMIC_ACQUIRE, "agent");
            xb_add(&bar[XB_XGEN(b.x)], 1u);
            asm volatile("s_waitcnt vmcnt(0)" ::: "memory");
        } else {
            XB_SPIN(xb_ld(&bar[XB_XGEN(b.x)]) == gen, bar);
            __builtin_amdgcn_fence(__ATOMIC_ACQUIRE, "agent");
            asm volatile("s_waitcnt vmcnt(0)" ::: "memory");
        }
    }
    __syncthreads();
}

struct Frame {
    LAS unsigned char* lds;
    volatile LAS unsigned* MISC;
    gu32* ctl;
    int tid, lane, wave, vcu, G;
};
__device__ __forceinline__ float wave_sum(float v) {
#pragma unroll
    for (int o = 1; o < 64; o <<= 1) v += __shfl_xor(v, o);
    return v;
}
__device__ __forceinline__ void transpose_item(const float* W, int N, bf16* WT, int ldt, int koff, LAS float* scr, int item, int lane) {
    const int nblk = N / 32, kb = item / nblk, nb = item % nblk, k0 = 64 * kb, n0 = 32 * nb;
#pragma unroll 8
    for (int i = 0; i < 32; ++i) { const int kk = 2 * i + (lane >> 5); scr[kk * 33 + (lane & 31)] = W[(size_t)(k0 + kk) * N + n0 + (lane & 31)]; }
    LDS_WAIT(); asm volatile("" ::: "memory");
    const int c = lane & 7;
#pragma unroll
    for (int j = 0; j < 4; ++j) { const int n = (lane >> 3) + 8 * j; const LAS float* s = scr + (8 * c) * 33 + n;
        v4u o; o.x = pk2(s[0 * 33], s[1 * 33]); o.y = pk2(s[2 * 33], s[3 * 33]); o.z = pk2(s[4 * 33], s[5 * 33]); o.w = pk2(s[6 * 33], s[7 * 33]);
        *(GAS v4u*)(WT + (size_t)(n0 + n) * ldt + koff + k0 + 8 * c) = o; }
    LDS_WAIT(); asm volatile("" ::: "memory");
}
__device__ __forceinline__ int opq_blk() { int c = blockIdx.x; asm volatile("" : "+s"(c)); return c; }
template <class T> __device__ __forceinline__ T* opq(T* p) { asm volatile("" : "+s"(p)); return p; }
__device__ __forceinline__ int opq_lane() { int l = threadIdx.x & 63; asm volatile("" : "+v"(l)); return l; }
struct Args { const float* in[36]; float* out; unsigned char* ws; int ph_lo, ph_hi, li, pad; };

__device__ __forceinline__ void convert_weights(Frame& F, const Args& a, int l) {
    const int lane = opq_lane();
    LAS float* scr = (LAS float*)(F.lds + RING_OFF + F.wave * 16384);
    const int gw = F.vcu * NWAVES + F.wave, NGW = F.G * NWAVES;
    unsigned char* ws = a.ws;
    constexpr int I_IN = 16 * 96, I_G = 16 * 128, I_B = 8 * 32, I_O = 16 * 32, I_1 = 16 * 128, I_2 = 64 * 32, I_GLU = 8 * 16;
    constexpr int NITEMS = I_IN + I_G + 4 * I_B + I_O + I_1 + I_2 + I_GLU;
    for (int it = gw; it < NITEMS; it += NGW) {
        int r = it;
        if (r < I_IN) { transpose_item(a.in[5] + (size_t)l * DM * DIN, DIN, (bf16*)(ws + WS_WIN), DM, 0, scr, r, lane); continue; } r -= I_IN;
        if (r < I_G) { transpose_item(a.in[29] + (size_t)l * DM * NGATE, NGATE, (bf16*)(ws + WS_WG), DM, 0, scr, r, lane); continue; } r -= I_G;
        if (r < 4 * I_B) { const int k = r / I_B; if (k > 0) transpose_item(a.in[28] + ((size_t)l * 4 + k) * WB * DM, DM, (bf16*)(ws + WS_WB), 4 * WB, k * WB, scr, r % I_B, lane); continue; } r -= 4 * I_B;
        if (r < I_O) { transpose_item(a.in[31] + (size_t)l * DM * DM, DM, (bf16*)(ws + WS_WO), DM, 0, scr, r, lane); continue; } r -= I_O;
        if (r < I_1) { transpose_item(a.in[33] + (size_t)l * DM * DFF, DFF, (bf16*)(ws + WS_W1), DM, 0, scr, r, lane); continue; } r -= I_1;
        if (r < I_2) { transpose_item(a.in[34] + (size_t)l * DFF * DM, DM, (bf16*)(ws + WS_W2), DFF, 0, scr, r, lane); continue; } r -= I_2;
        transpose_item(a.in[16] + (size_t)l * WB * WB, WB, (bf16*)(ws + WS_WGLU), WB, 0, scr, r, lane);
    }
}
__device__ __forceinline__ void normmod_rows(Frame& F, const float* x, const float* g, const float* sc, const float* sh, bf16* out) {
    const int lane = opq_lane();
    const int gw = F.vcu * NWAVES + F.wave, NGW = F.G * NWAVES;
    for (int m = gw; m < M; m += NGW) {
        const int b = m / SEQ;
        const GAS f32x4* xr = (const GAS f32x4*)(x + (size_t)m * DM) + lane;
        f32x4 v[4]; float s = 0.f;
#pragma unroll
        for (int j = 0; j < 4; ++j) { v[j] = xr[64 * j]; s += (v[j].x * v[j].x + v[j].y * v[j].y) + (v[j].z * v[j].z + v[j].w * v[j].w); }
        const float r = 1.0f / sqrtf(wave_sum(s) * (1.f / DM) + EPS);
        GAS unsigned long long* o8 = (GAS unsigned long long*)(out + (size_t)m * DM) + lane;
#pragma unroll
        for (int j = 0; j < 4; ++j) { const f32x4 gg = ((const GAS f32x4*)g)[lane + 64 * j], s1 = ((const GAS f32x4*)(sc + (size_t)b * 6 * DM))[lane + 64 * j], s0 = ((const GAS f32x4*)(sh + (size_t)b * 6 * DM))[lane + 64 * j];
            const f32x4 o = v[j] * r * gg * (1.0f + s1) + s0;
            o8[64 * j] = (unsigned long long)pk2(o.x, o.y) | ((unsigned long long)pk2(o.z, o.w) << 32); }
    }
}
__device__ __forceinline__ void final_rows(Frame& F, float* x, const float* g) {
    const int lane = opq_lane();
    const int gw = F.vcu * NWAVES + F.wave, NGW = F.G * NWAVES;
    for (int m = gw; m < M; m += NGW) {
        GAS f32x4* xr = (GAS f32x4*)(x + (size_t)m * DM) + lane;
        f32x4 v[4]; float s = 0.f;
#pragma unroll
        for (int j = 0; j < 4; ++j) { v[j] = xr[64 * j]; s += (v[j].x * v[j].x + v[j].y * v[j].y) + (v[j].z * v[j].z + v[j].w * v[j].w); }
        const float r = 1.0f / sqrtf(wave_sum(s) * (1.f / DM) + EPS);
#pragma unroll
        for (int j = 0; j < 4; ++j) xr[64 * j] = v[j] * r * ((const GAS f32x4*)g)[lane + 64 * j];
    }
}

typedef short bf16x8 __attribute__((ext_vector_type(8)));
typedef float f32x16 __attribute__((ext_vector_type(16)));
constexpr size_t WS_GWS = 38 * MiB + 512 * 1024;
__device__ __forceinline__ float sigmoid_acc(float x) { return 1.f / (1.f + expf(-x)); }
__device__ __forceinline__ float gelu_acc(float x) { const float u = 0.7978845608028654f * (x + 0.044715f * x * x * x); return x / (1.f + expf(-2.f * u)); }

__device__ __forceinline__ void ada_phase(Frame& F, const float* c, const float* ada_w, const float* ada_b, float* mod) {
    LAS float* sc = (LAS float*)(F.lds);
    LAS float* red = (LAS float*)(F.lds + 32768);
    const int tid = opq_lane() + 64 * F.wave;
    for (int e = tid; e < NB * DM; e += NWAVES * 64) { const int b = e >> 10, k = e & 1023; const float v = c[e]; sc[k * 8 + b] = v / (1.f + expf(-v)); }
    __syncthreads();
    for (int cb = blockIdx.x; cb < 256; cb += F.G) {
        const int cl = tid % 48, ks = tid / 48, colg = cb * 48 + cl, l = colg / (6 * DM), j = colg % (6 * DM);
        if (tid < 384) {
            float acc[8];
#pragma unroll
            for (int b = 0; b < 8; ++b) acc[b] = 0.f;
            const float* w = ada_w + ((size_t)l * DM + ks * 128) * 6 * DM + j;
#pragma unroll 4
            for (int k = 0; k < 128; ++k) { const float wv = w[(size_t)k * 6 * DM]; const LAS f32x4* s4 = (const LAS f32x4*)(sc + (ks * 128 + k) * 8); const f32x4 s0 = s4[0], s1 = s4[1];
                acc[0] = fmaf(s0.x, wv, acc[0]); acc[1] = fmaf(s0.y, wv, acc[1]); acc[2] = fmaf(s0.z, wv, acc[2]); acc[3] = fmaf(s0.w, wv, acc[3]);
                acc[4] = fmaf(s1.x, wv, acc[4]); acc[5] = fmaf(s1.y, wv, acc[5]); acc[6] = fmaf(s1.z, wv, acc[6]); acc[7] = fmaf(s1.w, wv, acc[7]); }
#pragma unroll
            for (int b = 0; b < 8; ++b) red[(ks * 8 + b) * 48 + cl] = acc[b];
        }
        __syncthreads();
        if (tid < 384) { const int b = tid / 48; float s = ada_b[l * 6 * DM + j];
#pragma unroll
            for (int k2 = 0; k2 < 8; ++k2) s += red[(k2 * 8 + b) * 48 + cl];
            mod[((size_t)l * NB + b) * 6 * DM + j] = s; }
        __syncthreads();
    }
}
__device__ __forceinline__ void small_weights(Frame& F, const Args& a, int l) {
    const int gt = F.vcu * (NWAVES * 64) + F.wave * 64 + opq_lane(), NT = F.G * NWAVES * 64;
    const float* pw = a.in[6] + (size_t)l * 4 * 128 * 128; const float* ps = a.in[7] + l * WB; const float* wb0 = a.in[28] + (size_t)l * 4 * WB * DM;
    bf16* WbT = (bf16*)(a.ws + WS_WB);
    for (int it = gt; it < 64 * 1024; it += NT) {
        const int n = it & 1023, c8 = it >> 10, g = c8 >> 4, c0 = (c8 & 15) * 8;
        float acc[8];
#pragma unroll
        for (int i = 0; i < 8; ++i) acc[i] = 0.f;
        for (int d = 0; d < 128; ++d) { const float wv = wb0[(size_t)(g * 128 + d) * DM + n] * ps[g * 128 + d];
#pragma unroll
            for (int i = 0; i < 8; ++i) acc[i] = fmaf(pw[(size_t)(g * 128 + c0 + i) * 128 + d], wv, acc[i]); }
        v4u o; o.x = pk2(acc[0], acc[1]); o.y = pk2(acc[2], acc[3]); o.z = pk2(acc[4], acc[5]); o.w = pk2(acc[6], acc[7]);
        *(GAS v4u*)(WbT + (size_t)n * (4 * WB) + c8 * 8) = o;
    }
    const float* gws = a.in[26] + (size_t)l * 4 * 128 * 128; bf16* G = (bf16*)(a.ws + WS_GWS);
    for (int it = gt; it < 4 * 128 * 128 / 2; it += NT) ((GAS unsigned*)G)[it] = pk2(gws[2 * it], gws[2 * it + 1]);
}
__device__ __forceinline__ void pool_phase(Frame& F, const unsigned char* ws) {
    const int gt = F.vcu * (NWAVES * 64) + F.wave * 64 + opq_lane(), NT = F.G * NWAVES * 64;
    const bf16* ZA = (const bf16*)(ws + WS_ZA); bf16* YS = (bf16*)(ws + WS_YS);
    for (int it = gt; it < M * 64; it += NT) {
        const int c8 = it & 63, m = it >> 6, t = m & (SEQ - 1), g = c8 >> 4, w = 2 << g;
        int lo = t - w / 2, hi = lo + w; lo = lo < 0 ? 0 : lo; hi = hi > SEQ ? SEQ : hi;
        float s[8];
#pragma unroll
        for (int i = 0; i < 8; ++i) s[i] = 0.f;
        const bf16* base = ZA + (size_t)(m - t) * DM + c8 * 8;
        for (int q = lo; q < hi; ++q) { const v4u r = *(const GAS v4u*)(base + (size_t)q * DM);
            s[0] += pg8::bf_lo(r.x); s[1] += pg8::bf_hi(r.x); s[2] += pg8::bf_lo(r.y); s[3] += pg8::bf_hi(r.y); s[4] += pg8::bf_lo(r.z); s[5] += pg8::bf_hi(r.z); s[6] += pg8::bf_lo(r.w); s[7] += pg8::bf_hi(r.w); }
        const v4u cz = *(const GAS v4u*)(base + (size_t)t * DM); const float inv = 1.f / (float)(hi - lo);
        v4u o; o.x = pk2(s[0] * inv - pg8::bf_lo(cz.x), s[1] * inv - pg8::bf_hi(cz.x)); o.y = pk2(s[2] * inv - pg8::bf_lo(cz.y), s[3] * inv - pg8::bf_hi(cz.y));
        o.z = pk2(s[4] * inv - pg8::bf_lo(cz.z), s[5] * inv - pg8::bf_hi(cz.z)); o.w = pk2(s[6] * inv - pg8::bf_lo(cz.w), s[7] * inv - pg8::bf_hi(cz.w));
        *(GAS v4u*)(YS + (size_t)m * (4 * WB) + c8 * 8) = o;
    }
}
__device__ __forceinline__ void gmlp_phase(Frame& F, const Args& a, int l) {
    const unsigned char* ws = a.ws;
    const bf16* ZC = (const bf16*)(ws + WS_ZC); bf16* YS = (bf16*)(ws + WS_YS); const bf16* GW = (const bf16*)(ws + WS_GWS);
    const float* ng = a.in[25] + l * WB; const float* bs = a.in[27] + l * 4 * 128;
    LAS float* rs = (LAS float*)(F.lds); LAS bf16* vnT = (LAS bf16*)(F.lds + 1024);
    const int lane = opq_lane(), w = F.wave, tid = w * 64 + lane;
    for (int unit = blockIdx.x; unit < 128 * 4; unit += F.G) {
        const int g = unit & 3, tok0 = (unit >> 2) * 128;
#pragma unroll 4
        for (int i = 0; i < 16; ++i) { const int p = w * 16 + i; const v4u r = *(const GAS v4u*)(ZC + (size_t)(tok0 + p) * DM + 512 + lane * 8);
            float s = pg8::bf_lo(r.x) * pg8::bf_lo(r.x) + pg8::bf_hi(r.x) * pg8::bf_hi(r.x) + pg8::bf_lo(r.y) * pg8::bf_lo(r.y) + pg8::bf_hi(r.y) * pg8::bf_hi(r.y)
                    + pg8::bf_lo(r.z) * pg8::bf_lo(r.z) + pg8::bf_hi(r.z) * pg8::bf_hi(r.z) + pg8::bf_lo(r.w) * pg8::bf_lo(r.w) + pg8::bf_hi(r.w) * pg8::bf_hi(r.w);
            s = wave_sum(s); if (lane == 0) rs[p] = 1.0f / sqrtf(s * (1.f / WB) + EPS); }
        __syncthreads();
#pragma unroll
        for (int e = tid; e < 2048; e += NWAVES * 64) { const int cc = e >> 7, p = e & 127;
            const v4u r = *(const GAS v4u*)(ZC + (size_t)(tok0 + p) * DM + 512 + g * 128 + cc * 8); const float sc = rs[p];
            const f32x4 g0 = *(const GAS f32x4*)(ng + g * 128 + cc * 8), g1 = *(const GAS f32x4*)(ng + g * 128 + cc * 8 + 4);
            LAS bf16* d = vnT + (cc * 8) * 136 + p;
            d[0 * 136] = (bf16)f2bf(pg8::bf_lo(r.x) * sc * g0.x); d[1 * 136] = (bf16)f2bf(pg8::bf_hi(r.x) * sc * g0.y); d[2 * 136] = (bf16)f2bf(pg8::bf_lo(r.y) * sc * g0.z); d[3 * 136] = (bf16)f2bf(pg8::bf_hi(r.y) * sc * g0.w);
            d[4 * 136] = (bf16)f2bf(pg8::bf_lo(r.z) * sc * g1.x); d[5 * 136] = (bf16)f2bf(pg8::bf_hi(r.z) * sc * g1.y); d[6 * 136] = (bf16)f2bf(pg8::bf_lo(r.w) * sc * g1.z); d[7 * 136] = (bf16)f2bf(pg8::bf_hi(r.w) * sc * g1.w); }
        __syncthreads();
        const int qt = w & 3, ch = w >> 2, lr = lane & 31, lh = lane >> 5;
        f32x16 acc0, acc1;
#pragma unroll
        for (int i = 0; i < 16; ++i) { acc0[i] = 0.f; acc1[i] = 0.f; }
        const bf16* arow = GW + ((size_t)g * 128 + qt * 32 + lr) * 128 + lh * 8;
        const LAS bf16* b0 = vnT + (ch * 64 + lr) * 136 + lh * 8; const LAS bf16* b1 = b0 + 32 * 136;
#pragma unroll
        for (int ks = 0; ks < 8; ++ks) { const bf16x8 av = *(const GAS bf16x8*)(arow + ks * 16); const bf16x8 bv0 = *(const LAS bf16x8*)(b0 + ks * 16), bv1 = *(const LAS bf16x8*)(b1 + ks * 16);
            acc0 = __builtin_amdgcn_mfma_f32_32x32x16_bf16(av, bv0, acc0, 0, 0, 0); acc1 = __builtin_amdgcn_mfma_f32_32x32x16_bf16(av, bv1, acc1, 0, 0, 0); }
#pragma unroll
        for (int r = 0; r < 16; ++r) { const int q = qt * 32 + (r & 3) + 8 * (r >> 2) + 4 * lh; const float bq = bs[g * 128 + q]; const size_t tk = (size_t)(tok0 + q);
            const int c0 = g * 128 + ch * 64 + lr;
            const float u0 = bf2f(ZC[tk * DM + c0]), u1 = bf2f(ZC[tk * DM + c0 + 32]);
            YS[tk * (4 * WB) + 3 * WB + c0] = (bf16)f2bf(u0 * (acc0[r] + bq)); YS[tk * (4 * WB) + 3 * WB + c0 + 32] = (bf16)f2bf(u1 * (acc1[r] + bq)); }
        __syncthreads();
    }
}
__device__ __forceinline__ void ssm_wave_naive(Frame& F, const Args& a, int l, int unit, LAS float* red  ) {
    const unsigned char* ws = a.ws; const bf16* ZA = (const bf16*)(ws + WS_ZA); bf16* YSSM = (bf16*)(ws + WS_YSSM);
    const int b = unit >> 5, g = unit & 31, p = opq_lane(), hh = p & 15, q = p >> 4;
    const float dsk = a.in[15][l * WB + g * 16 + hh];
#pragma unroll 1
    for (int dir = 0; dir < 2; ++dir) {
        const float lr = a.in[8][((l * 2 + dir) * 32 + g) * 64 + p], li = a.in[9][((l * 2 + dir) * 32 + g) * 64 + p], dt = expf(a.in[10][(l * 2 + dir) * 32 + g]);
        const float mag = expf(lr * dt), are = mag * cosf(li * dt), aim = mag * sinf(li * dt);
        const float den = lr * lr + li * li, nr = are - 1.f, fre = (nr * lr + aim * li) / den, fim = (aim * lr - nr * li) / den;
        float bbr[16], bbi[16], cr[16], ci[16];
#pragma unroll
        for (int h = 0; h < 16; ++h) { const float br = a.in[11][((size_t)(l * 32 + g) * 64 + p) * 16 + h], bi = a.in[12][((size_t)(l * 32 + g) * 64 + p) * 16 + h]; bbr[h] = fre * br - fim * bi; bbi[h] = fre * bi + fim * br;
            cr[h] = a.in[13][(((size_t)(l * 2 + dir) * 32 + g) * 16 + h) * 64 + p]; ci[h] = a.in[14][(((size_t)(l * 2 + dir) * 32 + g) * 16 + h) * 64 + p]; }
        float hre = 0.f, him = 0.f;
#pragma unroll 1
        for (int step = 0; step < SEQ; ++step) {
            const int t = dir ? SEQ - 1 - step : step; const size_t m = (size_t)b * SEQ + t;
            const bf16* zp = ZA + m * DM + 512 + g * 16;
            const v4u r0 = *(const GAS v4u*)zp, r1 = *(const GAS v4u*)(zp + 8);
            float u[16] = {pg8::bf_lo(r0.x), pg8::bf_hi(r0.x), pg8::bf_lo(r0.y), pg8::bf_hi(r0.y), pg8::bf_lo(r0.z), pg8::bf_hi(r0.z), pg8::bf_lo(r0.w), pg8::bf_hi(r0.w),
                           pg8::bf_lo(r1.x), pg8::bf_hi(r1.x), pg8::bf_lo(r1.y), pg8::bf_hi(r1.y), pg8::bf_lo(r1.z), pg8::bf_hi(r1.z), pg8::bf_lo(r1.w), pg8::bf_hi(r1.w)};
            float xre = 0.f, xim = 0.f;
#pragma unroll
            for (int h = 0; h < 16; ++h) { xre = fmaf(bbr[h], u[h], xre); xim = fmaf(bbi[h], u[h], xim); }
            const float nre = are * hre - aim * him + xre, nim = are * him + aim * hre + xim; hre = nre; him = nim;
#pragma unroll
            for (int h = 0; h < 16; ++h) red[h * 65 + p] = cr[h] * hre - ci[h] * him;
            asm volatile("s_waitcnt lgkmcnt(0)" ::: "memory");
            float s = 0.f;
#pragma unroll
            for (int k = 0; k < 16; ++k) s += red[hh * 65 + q * 16 + k];
            asm volatile("s_waitcnt lgkmcnt(0)" ::: "memory");
            s += __shfl_xor(s, 16); s += __shfl_xor(s, 32);
            if (p < 16) {
                if (dir == 0) YSSM[m * WB + g * 16 + hh] = (bf16)f2bf(dsk * bf2f(zp[hh]) + s);
                else YSSM[m * WB + g * 16 + hh] = (bf16)f2bf(gelu_acc(bf2f(YSSM[m * WB + g * 16 + hh]) + s));
            }
        }
    }
}
__device__ __forceinline__ void lru_wave_naive(Frame& F, const Args& a, int l, int unit, LAS float* xcs  ) {
    const unsigned char* ws = a.ws; const bf16* ZB = (const bf16*)(ws + WS_ZB); bf16* YS = (bf16*)(ws + WS_YS);
    const int b = unit >> 3, k = unit & 7, d = opq_lane(), ch = k * 64 + d;
    const float* cw = a.in[18] + l * 4 * WB; const float cw0 = cw[0 * WB + ch], cw1 = cw[1 * WB + ch], cw2 = cw[2 * WB + ch], cw3 = cw[3 * WB + ch], cb = a.in[19][l * WB + ch];
#pragma unroll 1
    for (int dir = 0; dir < 2; ++dir) {
        const float lamv = a.in[24][(l * 2 + dir) * WB + ch], ls = -log1pf(expf(-lamv));
        const float bav = a.in[21][(l * 2 + dir) * WB + ch], bxv = a.in[23][(l * 2 + dir) * WB + ch];
        const float* wa = a.in[20] + ((size_t)(l * 2 + dir) * 8 + k) * 64 * 64; const float* wx = a.in[22] + ((size_t)(l * 2 + dir) * 8 + k) * 64 * 64;
        float war[64], wxr[64];
#pragma unroll
        for (int c = 0; c < 64; ++c) { war[c] = wa[c * 64 + d]; wxr[c] = wx[c * 64 + d]; }
        float h = 0.f;
#pragma unroll 1
        for (int step = 0; step < SEQ; ++step) {
            const int t = dir ? SEQ - 1 - step : step; const size_t m = (size_t)b * SEQ + t;
            const bf16* zr = ZB + m * DM + ch;
            float xc = cb + cw2 * bf2f(zr[0]);
            if (t >= 2) xc += cw0 * bf2f(zr[-2 * DM]);
            if (t >= 1) xc += cw1 * bf2f(zr[-1 * DM]);
            if (t + 1 < SEQ) xc += cw3 * bf2f(zr[DM]);
            xcs[d] = xc;
            asm volatile("s_waitcnt lgkmcnt(0)" ::: "memory");
            float rp = bav, ip = bxv;
#pragma unroll
            for (int c = 0; c < 64; ++c) { const float xv = xcs[c]; rp = fmaf(xv, war[c], rp); ip = fmaf(xv, wxr[c], ip); }
            asm volatile("s_waitcnt lgkmcnt(0)" ::: "memory");
            const float r = sigmoid_acc(rp), ig = sigmoid_acc(ip), loga = 8.f * r * ls, av = expf(loga), mult = sqrtf(-expm1f(2.f * loga));
            h = av * h + mult * ig * xc;
            if (dir == 0) YS[m * (4 * WB) + 2 * WB + ch] = (bf16)f2bf(h);
            else YS[m * (4 * WB) + 2 * WB + ch] = (bf16)f2bf((bf2f(YS[m * (4 * WB) + 2 * WB + ch]) + h) * bf2f(zr[512]));
        }
    }
}
constexpr int PH_PER_LAYER = 9, PH_ADA = 0, PH_L0 = 1, PH_FIN = PH_L0 + PH_PER_LAYER * DEPTH, PH_COUNT = PH_FIN + 1;
enum { P_HN = 0, P_ZG = 1, P_MIX1 = 2, P_MIX2 = 3, P_BR = 4, P_WO = 5, P_H2 = 6, P_FF1 = 7, P_FF2 = 8 };
__global__ void __launch_bounds__(NWAVES * 64, 2) mk_fwd(Args args) {
    extern __shared__ __attribute__((aligned(16))) unsigned char lds[];
    Frame F;
    F.lds = (LAS unsigned char*)lds;
    F.MISC = (volatile LAS unsigned*)(F.lds + MISC_OFF);
    F.tid = threadIdx.x; F.lane = F.tid & 63; F.wave = __builtin_amdgcn_readfirstlane(F.tid >> 6);
    F.G = gridDim.x; { const int bx = blockIdx.x; F.vcu = (F.G % 8 == 0) ? (bx % 8) * (F.G / 8) + bx / 8 : bx; }
    unsigned char* ws = args.ws;
    F.ctl = (gu32*)(ws + WS_CTL);
    for (int u = F.tid; u < (LDS_BYTES - LDSCTL_OFF) / 4; u += NWAVES * 64) ((LAS unsigned*)(F.lds + LDSCTL_OFF))[u] = 0u;
    __syncthreads();
    XcdBarrier bar = xcd_barrier_post((unsigned*)(F.ctl + CW_BAR) + args.li * XCD_BAR_WORDS, F.MISC + 8);
    const int lo = args.ph_lo, hi = args.ph_hi;
#define IN(k) (lo <= (k) && (k) < hi)
#define SEAM(k) do { if (IN(k) && IN((k) + 1)) xcd_barrier(bar); } while (0)
    float* X = args.out;
    if (IN(PH_ADA)) { ada_phase(F, args.in[1], args.in[2], args.in[3], (float*)(ws + WS_MOD)); convert_weights(F, args, 0); small_weights(F, args, 0); }
    SEAM(PH_ADA);
    const float* MOD = (const float*)(ws + WS_MOD);
    bf16* H = (bf16*)(ws + WS_H);
#pragma unroll 1
    for (int l = 0; l < DEPTH; ++l) {
        const int pb = PH_L0 + PH_PER_LAYER * l;
        const float* mod = MOD + (size_t)l * NB * 6 * DM;
        const float* xin = l == 0 ? args.in[0] : X;
        if (IN(pb + P_HN)) { if (l > 0) { convert_weights(F, args, l); small_weights(F, args, l); } normmod_rows(F, xin, args.in[4] + l * DM, mod + 1 * DM, mod + 0 * DM, H); }
        SEAM(pb + P_HN);
        if (IN(pb + P_ZG)) {
            pg8::Gemm g{H, (const bf16*)(opq(ws) + WS_WIN), M, DIN, DM}; pg8::StaticOrder S; S.init(M, DIN, F.G, opq_blk());
            pg8::EpiBf16x<1> E{(bf16*)(opq(ws) + WS_ZA), (bf16*)(opq(ws) + WS_ZB), (bf16*)(opq(ws) + WS_ZC), DM, DM, 1536};
            pg8::gemm_phase<pg8::EpiBf16x<1>, pg8::StaticOrder, PG8_ALIGN, PG8_SP2>(F.lds + RING_OFF, g, S, E);
        }
        SEAM(pb + P_ZG);
        if (IN(pb + P_MIX1)) {
            pool_phase(F, ws);
            gmlp_phase(F, args, l);
            if (F.wave == 0) { for (int u = blockIdx.x; u < NB * 32; u += F.G) ssm_wave_naive(F, args, l, u, (LAS float*)(F.lds)); }
            else if (F.wave == 1) { for (int u = blockIdx.x; u < NB * 8; u += F.G) lru_wave_naive(F, args, l, u, (LAS float*)(F.lds + 16384)); }
        }
        SEAM(pb + P_MIX1);
        if (IN(pb + P_MIX2)) {
            { pg8::Gemm g{(const bf16*)(opq(ws) + WS_YSSM), (const bf16*)(opq(ws) + WS_WGLU), M, WB, WB}; pg8::StaticOrder S; S.init(M, WB, F.G, opq_blk());
              pg8::EpiGlu E{(const bf16*)(opq(ws) + WS_YSSM), WB, (bf16*)(opq(ws) + WS_YS), 4 * WB, WB, args.in[17] + l * WB};
              pg8::gemm_phase<pg8::EpiGlu, pg8::StaticOrder, PG8_ALIGN, PG8_SP2>(F.lds + RING_OFF, g, S, E); }
            { pg8::Gemm g{H, (const bf16*)(opq(ws) + WS_WG), M, NGATE, DM}; pg8::StaticOrder S; S.init(M, NGATE, F.G, opq_blk());
              pg8::EpiGate E{opq(ws) + WS_GATES, NGATE / 256, args.in[30] + l * NGATE};
              pg8::gemm_phase<pg8::EpiGate, pg8::StaticOrder, PG8_ALIGN, PG8_SP2>(F.lds + RING_OFF, g, S, E); }
        }
        SEAM(pb + P_MIX2);
        if (IN(pb + P_BR)) {
            pg8::Gemm g{(const bf16*)(opq(ws) + WS_YS), (const bf16*)(opq(ws) + WS_WB), M, DM, 4 * WB}; pg8::StaticOrder S; S.init(M, DM, F.G, opq_blk());
            pg8::EpiBranch E{opq(ws) + WS_GATES, (bf16*)(opq(ws) + WS_MERGED), DM};
            pg8::gemm_phase<pg8::EpiBranch, pg8::StaticOrder, PG8_ALIGN, PG8_SP2>(F.lds + RING_OFF, g, S, E);
        }
        SEAM(pb + P_BR);
        if (IN(pb + P_WO)) {
            pg8::Gemm g{(const bf16*)(opq(ws) + WS_MERGED), (const bf16*)(opq(ws) + WS_WO), M, DM, DM}; pg8::StaticOrder S; S.init(M, DM, F.G, opq_blk());
            pg8::EpiRes E{xin, X, DM, mod + 2 * DM, 6 * DM, SEQ / 256};
            pg8::gemm_phase<pg8::EpiRes, pg8::StaticOrder, PG8_ALIGN, PG8_SP2>(F.lds + RING_OFF, g, S, E);
        }
        SEAM(pb + P_WO);
        if (IN(pb + P_H2)) normmod_rows(F, X, args.in[32] + l * DM, mod + 4 * DM, mod + 3 * DM, H);
        SEAM(pb + P_H2);
        if (IN(pb + P_FF1)) {
            pg8::Gemm g{H, (const bf16*)(opq(ws) + WS_W1), M, DFF, DM}; pg8::StaticOrder S; S.init(M, DFF, F.G, opq_blk());
            pg8::EpiBf16x<2> E{(bf16*)(opq(ws) + WS_F1), nullptr, nullptr, DFF, 0, 0};
            pg8::gemm_phase<pg8::EpiBf16x<2>, pg8::StaticOrder, PG8_ALIGN, PG8_SP2>(F.lds + RING_OFF, g, S, E);
        }
        SEAM(pb + P_FF1);
        if (IN(pb + P_FF2)) {
            pg8::Gemm g{(const bf16*)(opq(ws) + WS_F1), (const bf16*)(opq(ws) + WS_W2), M, DM, DFF}; pg8::StaticOrder S; S.init(M, DM, F.G, opq_blk());
            pg8::EpiRes E{X, X, DM, mod + 5 * DM, 6 * DM, SEQ / 256};
            pg8::gemm_phase<pg8::EpiRes, pg8::StaticOrder, PG8_ALIGN, PG8_SP2>(F.lds + RING_OFF, g, S, E);
        }
        SEAM(pb + P_FF2);
    }
    if (IN(PH_FIN)) final_rows(F, X, args.in[35]);
#undef IN
#undef SEAM
}

extern "C" void kernel_launch(void* const* d_in, const int* in_sizes, int n_in, void* d_out, int out_size, void* d_ws, size_t ws_size, hipStream_t stream) {
    static int grid = 0;
    if (grid == 0) {
        if (n_in != 36 || in_sizes[0] != M * DM || out_size != M * DM || ws_size < WS_END) { fprintf(stderr, "kernel_launch: unexpected problem: n_in %d in0 %d out %d ws %zu; nothing launched\n", n_in, n_in > 0 ? in_sizes[0] : -1, out_size, ws_size); grid = -1; return; }
        int dev = 0, cus = 0, per_cu = 0;
        if (hipGetDevice(&dev) != hipSuccess || hipDeviceGetAttribute(&cus, hipDeviceAttributeMultiprocessorCount, dev) != hipSuccess) { grid = -1; return; }
        if (hipFuncSetAttribute((const void*)mk_fwd, hipFuncAttributeMaxDynamicSharedMemorySize, LDS_BYTES) != hipSuccess) { fprintf(stderr, "kernel_launch: hipFuncSetAttribute failed\n"); grid = -1; return; }
        if (hipOccupancyMaxActiveBlocksPerMultiprocessor(&per_cu, (const void*)mk_fwd, NWAVES * 64, LDS_BYTES) != hipSuccess || per_cu < 1) fprintf(stderr, "kernel_launch: occupancy query says %d\n", per_cu);
        (void)hipGetLastError();
        grid = cus;
        fprintf(stderr, "kernel_launch: grid %d (occupancy query %d per CU), ws %zu bytes\n", grid, per_cu, ws_size);
    }
    if (grid < 0) return;
    unsigned char* ws = (unsigned char*)d_ws;
    (void)hipMemsetAsync(ws + WS_CTL, 0, CTL_ZERO_BYTES, stream);
    Args a{};
    for (int i = 0; i < 36; ++i) a.in[i] = (const float*)d_in[i];
    a.out = (float*)d_out; a.ws = ws; a.ph_lo = 0; a.ph_hi = PH_COUNT; a.li = 0;
    hipLaunchKernelGGL(mk_fwd, dim3(grid), dim3(NWAVES * 64), LDS_BYTES, stream, a);
}
```

```cpp
#include <hip/hip_runtime.h>
#include <stdint.h>
#include <stdio.h>
namespace pg8 {
#define PG8_LAS __attribute__((address_space(3)))
typedef unsigned short bf16_t;
typedef short bf16x8 __attribute__((ext_vector_type(8)));
typedef float f32x4 __attribute__((ext_vector_type(4)));
typedef unsigned u32x4 __attribute__((ext_vector_type(4)));
constexpr int BM = 256, BK = 64, HALF = 128, HTB = HALF * BK * 2  , STAGE_BYTES = 8 * HTB, NXCD = 8, WGM = 8;

__host__ __device__ __forceinline__ int lds_byte(int r, int c) { const int st = (r >> 4) * 2 + (c >> 5), rr = r & 15, cc = c & 31, ob = rr * 64 + cc * 2; return st * 1024 + (ob ^ (((ob >> 9) & 1) << 5)); }
__host__ __device__ __forceinline__ void stage_rc(int b, int& R, int& C) { const int st = b / 1024, sb = b % 1024, swz = sb ^ (((sb >> 9) & 1) << 5); R = (st >> 1) * 16 + swz / 64; C = (st & 1) * 32 + (swz % 64) / 2; }
__host__ __device__ __forceinline__ int perm32(int rho) { const int n = rho >> 4, i = rho & 15; return 8 * (i >> 2) + 4 * n + (i & 3); }

struct Unit { int pm, pn; };
struct Gemm { const bf16_t* A; const bf16_t* Bt; int M, N, K; };

struct StaticOrder {
    int nM, nN, nwg, G, c;
    __host__ __device__ void init(int M, int N, int G_, int c_) { nM = M / BM; nN = N / BM; nwg = nM * nN; G = G_; c = c_; }
    __host__ __device__ bool next(int i, Unit& u) const {
        const long L = (long)i * G + c; if (L >= nwg) return false;
        int wgid = (int)L; { const int q = nwg / NXCD, r = nwg % NXCD, xcd = wgid % NXCD, off = wgid / NXCD; wgid = (xcd < r ? xcd * (q + 1) : r * (q + 1) + (xcd - r) * q) + off; }
        const int nig = WGM * nN, gid = wgid / nig, fm = gid * WGM, gsz = (nM - fm) < WGM ? (nM - fm) : WGM;
        u.pm = fm + ((wgid % nig) % gsz); u.pn = (wgid % nig) / gsz; return true;
    }
    __device__ __forceinline__ void a_ready(const Unit&) const {}
    __device__ __forceinline__ void done(const Unit&) const {}
};

__device__ __forceinline__ unsigned cvt_pk_bf16(float lo, float hi) { unsigned r; asm volatile("v_cvt_pk_bf16_f32 %0, %1, %2" : "=v"(r) : "v"(lo), "v"(hi)); return r; }
__device__ __forceinline__ float fast_sigmoid(float x) { return __builtin_amdgcn_rcpf(1.0f + __builtin_amdgcn_exp2f(-1.4426950408889634f * x)); }
__device__ __forceinline__ float gelu_tanh(float x) { const float u = x * (0.7978845608028654f + 0.0356774081363001f * x * x); return x * __builtin_amdgcn_rcpf(1.0f + __builtin_amdgcn_exp2f(-2.885390081777927f * u)); }
__device__ __forceinline__ float bf_lo(unsigned w) { return __builtin_bit_cast(float, w << 16); }
__device__ __forceinline__ float bf_hi(unsigned w) { return __builtin_bit_cast(float, w & 0xffff0000u); }

template <int ACT> struct EpiBf16x {
    static constexpr bool PERM = true, AFTER_DRAIN = false, HAS_MID = false;
    bf16_t *O0, *O1, *O2; int ldc; int split_cols; int gelu_from;
    __device__ __forceinline__ void operator()(const f32x4 (&acc)[2][2][4][2], const Unit& u, int wr, int wc, int fr, int fq) const {
        const int row0 = u.pm * BM + wr * 64 + fr; int colt = u.pn * BM; bf16_t* base = O0;
        const bool act1 = (ACT == 1) && (colt >= gelu_from);
        if (split_cols) { const int t = colt / split_cols; base = t == 0 ? O0 : (t == 1 ? O1 : O2); colt -= t * split_cols; }
        const int col0 = colt + wc * 32 + 8 * fq;
#pragma unroll
        for (int ai = 0; ai < 2; ++ai)
#pragma unroll
            for (int m = 0; m < 4; ++m) { bf16_t* rowp = base + (size_t)(row0 + ai * HALF + m * 16) * ldc + col0;
#pragma unroll
                for (int bj = 0; bj < 2; ++bj) { f32x4 v0 = acc[ai][bj][m][0], v1 = acc[ai][bj][m][1];
                    if (ACT == 1) { if (act1) {
#pragma unroll
                        for (int j = 0; j < 4; ++j) { v0[j] = gelu_tanh(v0[j]); v1[j] = gelu_tanh(v1[j]); } } }
                    if (ACT == 2) {
#pragma unroll
                        for (int j = 0; j < 4; ++j) { const float a = fmaxf(v0[j], 0.f), b = fmaxf(v1[j], 0.f); v0[j] = a * a; v1[j] = b * b; } }
                    u32x4 w; w.x = cvt_pk_bf16(v0[0], v0[1]); w.y = cvt_pk_bf16(v0[2], v0[3]); w.z = cvt_pk_bf16(v1[0], v1[1]); w.w = cvt_pk_bf16(v1[2], v1[3]);
                    *(u32x4*)(rowp + bj * HALF) = w; } }
    }
};
struct EpiGlu {
    static constexpr bool PERM = true, AFTER_DRAIN = false, HAS_MID = false;
    const bf16_t* Y; int ldy; bf16_t* O; int ldo; int ocol; const float* bias;
    __device__ __forceinline__ void operator()(const f32x4 (&acc)[2][2][4][2], const Unit& u, int wr, int wc, int fr, int fq) const {
        const int row0 = u.pm * BM + wr * 64 + fr, col0 = u.pn * BM + wc * 32 + 8 * fq;
        f32x4 bv[2][2];
#pragma unroll
        for (int bj = 0; bj < 2; ++bj)
#pragma unroll
            for (int n = 0; n < 2; ++n) bv[bj][n] = *(const f32x4*)(bias + col0 + bj * HALF + 4 * n);
#pragma unroll
        for (int ai = 0; ai < 2; ++ai)
#pragma unroll
            for (int m = 0; m < 4; ++m) { const size_t r = (size_t)(row0 + ai * HALF + m * 16);
#pragma unroll
                for (int bj = 0; bj < 2; ++bj) { const u32x4 yv = *(const u32x4*)(Y + r * ldy + col0 + bj * HALF);
                    const f32x4 a0 = acc[ai][bj][m][0] + bv[bj][0], a1 = acc[ai][bj][m][1] + bv[bj][1];
                    u32x4 w;
                    w.x = cvt_pk_bf16(bf_lo(yv.x) * fast_sigmoid(a0[0]), bf_hi(yv.x) * fast_sigmoid(a0[1]));
                    w.y = cvt_pk_bf16(bf_lo(yv.y) * fast_sigmoid(a0[2]), bf_hi(yv.y) * fast_sigmoid(a0[3]));
                    w.z = cvt_pk_bf16(bf_lo(yv.z) * fast_sigmoid(a1[0]), bf_hi(yv.z) * fast_sigmoid(a1[1]));
                    w.w = cvt_pk_bf16(bf_lo(yv.w) * fast_sigmoid(a1[2]), bf_hi(yv.w) * fast_sigmoid(a1[3]));
                    *(u32x4*)(O + r * ldo + ocol + col0 + bj * HALF) = w; } }
    }
};
typedef unsigned u32x2 __attribute__((ext_vector_type(2)));
__device__ __forceinline__ unsigned gate_q(float x) { float q = 255.0f * fast_sigmoid(x) + 0.5f; q = fminf(fmaxf(q, 1.0f), 255.0f); return (unsigned)q; }
struct EpiGate {
    static constexpr bool PERM = true, AFTER_DRAIN = false, HAS_MID = false;
    unsigned char* G; int ntn; const float* bias;
    __device__ __forceinline__ void operator()(const f32x4 (&acc)[2][2][4][2], const Unit& u, int wr, int wc, int fr, int fq) const {
        const int wid = wr * 4 + wc, lane = fq * 16 + fr, col0 = u.pn * BM + wc * 32 + 8 * fq;
        unsigned char* tile = G + ((size_t)u.pm * ntn + u.pn) * 65536 + (size_t)wid * 16 * 512 + lane * 8;
        f32x4 bv[2][2];
#pragma unroll
        for (int bj = 0; bj < 2; ++bj)
#pragma unroll
            for (int n = 0; n < 2; ++n) bv[bj][n] = *(const f32x4*)(bias + col0 + bj * HALF + 4 * n);
#pragma unroll
        for (int ai = 0; ai < 2; ++ai)
#pragma unroll
            for (int m = 0; m < 4; ++m)
#pragma unroll
                for (int bj = 0; bj < 2; ++bj) { const f32x4 a0 = acc[ai][bj][m][0] + bv[bj][0], a1 = acc[ai][bj][m][1] + bv[bj][1];
                    u32x2 w;
                    w.x = gate_q(a0[0]) | (gate_q(a0[1]) << 8) | (gate_q(a0[2]) << 16) | (gate_q(a0[3]) << 24);
                    w.y = gate_q(a1[0]) | (gate_q(a1[1]) << 8) | (gate_q(a1[2]) << 16) | (gate_q(a1[3]) << 24);
                    *(u32x2*)(tile + ((ai * 4 + m) * 2 + bj) * 512) = w; }
    }
};
struct EpiBranch {
    static constexpr bool PERM = true, AFTER_DRAIN = false, HAS_MID = true;
    const unsigned char* G; bf16_t* O; int ldc;
    __device__ __forceinline__ void mid(f32x4 (&acc)[2][2][4][2], const Unit& u, int s, int wid, int lane) const {
        const unsigned char* ta = G + ((size_t)u.pm * 16 + 4 * (s - 1) + u.pn) * 65536 + (size_t)wid * 16 * 512 + lane * 8;
        const unsigned char* tb = ta + (size_t)4 * 65536;
#pragma unroll
        for (int ai = 0; ai < 2; ++ai)
#pragma unroll
            for (int m = 0; m < 4; ++m)
#pragma unroll
                for (int bj = 0; bj < 2; ++bj) { const int o = ((ai * 4 + m) * 2 + bj) * 512; const u32x2 a = *(const u32x2*)(ta + o), b = *(const u32x2*)(tb + o);
#pragma unroll
                    for (int j = 0; j < 4; ++j) {
                        acc[ai][bj][m][0][j] *= (float)((a.x >> (8 * j)) & 255u) * __builtin_amdgcn_rcpf((float)((b.x >> (8 * j)) & 255u));
                        acc[ai][bj][m][1][j] *= (float)((a.y >> (8 * j)) & 255u) * __builtin_amdgcn_rcpf((float)((b.y >> (8 * j)) & 255u)); } }
    }
    __device__ __forceinline__ void operator()(const f32x4 (&acc)[2][2][4][2], const Unit& u, int wr, int wc, int fr, int fq) const {
        const int wid = wr * 4 + wc, lane = fq * 16 + fr;
        const unsigned char* ta = G + ((size_t)u.pm * 16 + 12 + u.pn) * 65536 + (size_t)wid * 16 * 512 + lane * 8;
        const int row0 = u.pm * BM + wr * 64 + fr, col0 = u.pn * BM + wc * 32 + 8 * fq;
#pragma unroll
        for (int ai = 0; ai < 2; ++ai)
#pragma unroll
            for (int m = 0; m < 4; ++m) { bf16_t* rowp = O + (size_t)(row0 + ai * HALF + m * 16) * ldc + col0;
#pragma unroll
                for (int bj = 0; bj < 2; ++bj) { const u32x2 a = *(const u32x2*)(ta + ((ai * 4 + m) * 2 + bj) * 512); f32x4 v0 = acc[ai][bj][m][0], v1 = acc[ai][bj][m][1];
#pragma unroll
                    for (int j = 0; j < 4; ++j) { v0[j] *= (float)((a.x >> (8 * j)) & 255u) * (1.0f / 255.0f); v1[j] *= (float)((a.y >> (8 * j)) & 255u) * (1.0f / 255.0f); }
                    u32x4 w; w.x = cvt_pk_bf16(v0[0], v0[1]); w.y = cvt_pk_bf16(v0[2], v0[3]); w.z = cvt_pk_bf16(v1[0], v1[1]); w.w = cvt_pk_bf16(v1[2], v1[3]);
                    *(u32x4*)(rowp + bj * HALF) = w; } }
    }
};
struct EpiRes {
    static constexpr bool PERM = false, AFTER_DRAIN = false, HAS_MID = false;
    const float* xin; float* xout; int ldc; const float* gate; int gld; int tiles_per_batch;
    __device__ __forceinline__ void operator()(const f32x4 (&acc)[2][2][4][2], const Unit& u, int wr, int wc, int fr, int fq) const {
        const int row0 = u.pm * BM + wr * 64 + fr, col0 = u.pn * BM + wc * 32 + 4 * fq;
        const float* gp = gate + (size_t)(u.pm / tiles_per_batch) * gld + col0;
        f32x4 gv[2][2];
#pragma unroll
        for (int bj = 0; bj < 2; ++bj)
#pragma unroll
            for (int n = 0; n < 2; ++n) gv[bj][n] = *(const f32x4*)(gp + bj * HALF + n * 16);
#pragma unroll
        for (int ai = 0; ai < 2; ++ai)
#pragma unroll
            for (int m = 0; m < 4; ++m) { const size_t off = (size_t)(row0 + ai * HALF + m * 16) * ldc + col0;
#pragma unroll
                for (int bj = 0; bj < 2; ++bj)
#pragma unroll
                    for (int n = 0; n < 2; ++n) { const f32x4 xi = *(const f32x4*)(xin + off + bj * HALF + n * 16); *(f32x4*)(xout + off + bj * HALF + n * 16) = xi + gv[bj][n] * acc[ai][bj][m][n]; } }
    }
};
template <class Epi, class Sched, bool ALIGN_EPI = false, bool SP2 = false>
__device__ __forceinline__ void gemm_phase(PG8_LAS unsigned char* lds, const Gemm g, const Sched& S, const Epi& E) {
    int tid_ = threadIdx.x; asm volatile("" : "+v"(tid_)); const int tid = tid_, wid = __builtin_amdgcn_readfirstlane(tid >> 6), lane = tid & 63, wr = wid >> 2, wc = wid & 3, fr = lane & 15, fq = lane >> 4;
    const int K = g.K, nt = K / BK;
    unsigned voffA[2], voffB[2];
#pragma unroll
    for (int i = 0; i < 2; ++i) { int R, C; stage_rc(tid * 16 + i * 8192, R, C); const int Rb = Epi::PERM ? ((R & ~31) + perm32(R & 31)) : R;
        voffA[i] = (unsigned)(R * K + C) * 2u; voffB[i] = (unsigned)(Rb * K + C) * 2u; }
    const size_t kstep = (size_t)(BK * 2);
    const size_t hstep = (size_t)HALF * K * 2;
    const size_t tstep = 2 * hstep;
    const unsigned ldsw = (unsigned)wid * 1024u;
    const int aoff = lds_byte(wr * 64 + fr, fq * 8), boff = lds_byte(wc * 32 + fr, fq * 8);
#define PG8_SA(b, h) (((b) * 2 + (h)) * HTB)
#define PG8_SB(b, h) ((4 + (b) * 2 + (h)) * HTB)
#define PG8_STAGE(bufoff, gbase, voff) do { _Pragma("unroll") for (int _i = 0; _i < 2; ++_i) \
        __builtin_amdgcn_global_load_lds((const unsigned*)((const char*)(gbase) + (voff)[_i]), (PG8_LAS unsigned*)(lds + (bufoff) + ldsw + _i * 8192), 16, 0, 0); } while (0)
#define PG8_LDA(dst, b, h) do { _Pragma("unroll") for (int m = 0; m < 4; ++m) _Pragma("unroll") for (int k = 0; k < 2; ++k) dst[m][k] = *(const PG8_LAS bf16x8*)(lds + PG8_SA(b, h) + aoff + m * 2048 + k * 1024); } while (0)
#define PG8_LDB(dst, b, h) do { _Pragma("unroll") for (int n = 0; n < 2; ++n) _Pragma("unroll") for (int k = 0; k < 2; ++k) dst[n][k] = *(const PG8_LAS bf16x8*)(lds + PG8_SB(b, h) + boff + n * 2048 + k * 1024); } while (0)
#define PG8_MMA(ai, bj, At, Bt) do { __builtin_amdgcn_s_setprio(1); _Pragma("unroll") for (int m = 0; m < 4; ++m) _Pragma("unroll") for (int n = 0; n < 2; ++n) _Pragma("unroll") for (int k = 0; k < 2; ++k) \
        acc[ai][bj][m][n] = __builtin_amdgcn_mfma_f32_16x16x32_bf16(Bt[n][k], At[m][k], acc[ai][bj][m][n], 0, 0, 0); __builtin_amdgcn_s_setprio(0); } while (0)
#define PG8_WAIT_V(n) asm volatile("s_waitcnt vmcnt(" #n ")" ::: "memory")
#define PG8_WAIT_L(n) asm volatile("s_waitcnt lgkmcnt(" #n ")" ::: "memory")
#define PG8_BAR __builtin_amdgcn_s_barrier()
#define PG8_SCHED __builtin_amdgcn_sched_barrier(0)
    Unit cur, nxt; int ui = 0;
    if (!S.next(0, cur)) return;
    f32x4 acc[2][2][4][2];
#pragma unroll
    for (int a = 0; a < 2; ++a)
#pragma unroll
        for (int b = 0; b < 2; ++b)
#pragma unroll
            for (int m = 0; m < 4; ++m)
#pragma unroll
                for (int n = 0; n < 2; ++n) acc[a][b][m][n] = (f32x4){0.f, 0.f, 0.f, 0.f};
    bf16x8 At[4][2], B0[2][2], B1[2][2];
    const char* cA = (const char*)g.A + (size_t)cur.pm * tstep; const char* cB = (const char*)g.Bt + (size_t)cur.pn * tstep;
    S.a_ready(cur);
    if constexpr (SP2) {
        PG8_STAGE(PG8_SB(0, 0), cB, voffB); PG8_STAGE(PG8_SB(0, 1), cB + hstep, voffB); PG8_STAGE(PG8_SA(0, 0), cA, voffA); PG8_STAGE(PG8_SA(0, 1), cA + hstep, voffA);
        if (wr == 1) PG8_BAR;
        PG8_WAIT_V(2); PG8_BAR;
        PG8_STAGE(PG8_SB(1, 0), cB + kstep, voffB); PG8_STAGE(PG8_SA(1, 0), cA + kstep, voffA); PG8_STAGE(PG8_SB(1, 1), cB + hstep + kstep, voffB);
        PG8_WAIT_V(6); PG8_BAR;
    } else {
        PG8_STAGE(PG8_SB(0, 0), cB, voffB); PG8_STAGE(PG8_SA(0, 0), cA, voffA); PG8_STAGE(PG8_SB(0, 1), cB + hstep, voffB); PG8_STAGE(PG8_SA(0, 1), cA + hstep, voffA);
        if (wr == 1) PG8_BAR;
        PG8_WAIT_V(4); PG8_BAR;
        PG8_STAGE(PG8_SB(1, 0), cB + kstep, voffB); PG8_STAGE(PG8_SA(1, 0), cA + kstep, voffA); PG8_STAGE(PG8_SB(1, 1), cB + hstep + kstep, voffB);
        PG8_WAIT_V(6); PG8_BAR;
    }
    for (;;) {
        const bool has_next = S.next(ui + 1, nxt);
        const char* nA = has_next ? (const char*)g.A + (size_t)nxt.pm * tstep : cA; const char* nB = has_next ? (const char*)g.Bt + (size_t)nxt.pn * tstep : cB;
        for (int t = 0; t < nt; t += 2) {
            const bool last = (t == nt - 2);
            if constexpr (Epi::HAS_MID) { if (t != 0 && (t & 7) == 0) E.mid(acc, cur, t >> 3, wid, lane); }
            const char* a1 = cA + (size_t)(t + 1) * kstep;
            const char* a2 = last ? nA : cA + (size_t)(t + 2) * kstep; const char* b2 = last ? nB : cB + (size_t)(t + 2) * kstep;
            const char* a3 = a2 + kstep; const char* b3 = b2 + kstep;
            if (last && has_next) S.a_ready(nxt);
            if constexpr (SP2) {
            PG8_LDB(B0, 0, 0); PG8_LDB(B1, 0, 1); PG8_SCHED; PG8_LDA(At, 0, 0); PG8_STAGE(PG8_SA(1, 1), a1 + hstep, voffA);
            PG8_WAIT_V(8); PG8_WAIT_L(0); PG8_BAR; PG8_MMA(0, 0, At, B0); PG8_MMA(0, 1, At, B1); PG8_BAR; PG8_SCHED;
            PG8_LDA(At, 0, 1); PG8_STAGE(PG8_SB(0, 0), b2, voffB); PG8_STAGE(PG8_SB(0, 1), b2 + hstep, voffB); PG8_STAGE(PG8_SA(0, 0), a2, voffA);
            PG8_WAIT_V(8); PG8_WAIT_L(0); PG8_BAR; PG8_MMA(1, 0, At, B0); PG8_MMA(1, 1, At, B1); PG8_BAR; PG8_SCHED;
            PG8_LDB(B0, 1, 0); PG8_LDB(B1, 1, 1); PG8_SCHED; PG8_LDA(At, 1, 0); PG8_STAGE(PG8_SA(0, 1), a2 + hstep, voffA);
            PG8_WAIT_V(8); PG8_WAIT_L(0); PG8_BAR; PG8_MMA(0, 0, At, B0); PG8_MMA(0, 1, At, B1); PG8_BAR; PG8_SCHED;
            PG8_LDA(At, 1, 1); PG8_STAGE(PG8_SB(1, 0), b3, voffB); PG8_STAGE(PG8_SB(1, 1), b3 + hstep, voffB); PG8_STAGE(PG8_SA(1, 0), a3, voffA);
            PG8_WAIT_V(8); PG8_WAIT_L(0); PG8_BAR; PG8_MMA(1, 0, At, B0); PG8_MMA(1, 1, At, B1); PG8_BAR; PG8_SCHED;
            } else {
            PG8_LDB(B0, 0, 0); PG8_SCHED; PG8_LDA(At, 0, 0); PG8_STAGE(PG8_SA(1, 1), a1 + hstep, voffA);
            PG8_WAIT_L(8); PG8_BAR; PG8_WAIT_L(0); PG8_MMA(0, 0, At, B0); PG8_BAR; PG8_SCHED;
            PG8_LDB(B1, 0, 1); PG8_STAGE(PG8_SB(0, 0), b2, voffB);
            PG8_BAR; PG8_WAIT_L(0); PG8_MMA(0, 1, At, B1); PG8_BAR;
            PG8_LDA(At, 0, 1); PG8_STAGE(PG8_SA(0, 0), a2, voffA);
            PG8_BAR; PG8_WAIT_L(0); PG8_MMA(1, 0, At, B0); PG8_BAR; PG8_SCHED;
            PG8_STAGE(PG8_SB(0, 1), b2 + hstep, voffB);
            PG8_WAIT_V(6); PG8_BAR; PG8_MMA(1, 1, At, B1); PG8_BAR;
            PG8_LDB(B0, 1, 0); PG8_SCHED; PG8_LDA(At, 1, 0); PG8_STAGE(PG8_SA(0, 1), a2 + hstep, voffA);
            PG8_WAIT_L(8); PG8_BAR; PG8_WAIT_L(0); PG8_MMA(0, 0, At, B0); PG8_BAR; PG8_SCHED;
            PG8_LDB(B1, 1, 1); PG8_STAGE(PG8_SB(1, 0), b3, voffB);
            PG8_BAR; PG8_WAIT_L(0); PG8_MMA(0, 1, At, B1); PG8_BAR;
            PG8_LDA(At, 1, 1); PG8_STAGE(PG8_SA(1, 0), a3, voffA);
            PG8_BAR; PG8_WAIT_L(0); PG8_MMA(1, 0, At, B0); PG8_BAR; PG8_SCHED;
            PG8_STAGE(PG8_SB(1, 1), b3 + hstep, voffB);
            PG8_WAIT_V(6); PG8_BAR; PG8_MMA(1, 1, At, B1); PG8_BAR;
            }
        }
        if constexpr (ALIGN_EPI) { if (wr == 0) PG8_BAR; }
        if constexpr (!Epi::AFTER_DRAIN) { E(acc, cur, wr, wc, fr, fq); S.done(cur); }
        if (!has_next) break;
#pragma unroll
        for (int a = 0; a < 2; ++a)
#pragma unroll
            for (int b = 0; b < 2; ++b)
#pragma unroll
                for (int m = 0; m < 4; ++m)
#pragma unroll
                    for (int n = 0; n < 2; ++n) acc[a][b][m][n] = (f32x4){0.f, 0.f, 0.f, 0.f};
        cur = nxt; cA = nA; cB = nB; ++ui;
        if constexpr (ALIGN_EPI) { if (wr == 1) PG8_BAR; }
    }
    PG8_WAIT_V(0);
    if constexpr (!ALIGN_EPI) { if (wr == 0) PG8_BAR; }
    PG8_BAR;
    if constexpr (Epi::AFTER_DRAIN) { E.fused(acc, cur, wr, wc, fr, fq, lds, wid, lane); S.done(cur); }
#undef PG8_SA
#undef PG8_SB
#undef PG8_STAGE
#undef PG8_LDA
#undef PG8_LDB
#undef PG8_MMA
#undef PG8_WAIT_V
#undef PG8_WAIT_L
#undef PG8_BAR
#undef PG8_SCHED
}
}

#ifndef PG8_SP2
#define PG8_SP2 true
#endif
#ifndef PG8_ALIGN
#define PG8_ALIGN true
#endif
constexpr int NWAVES = 8;
constexpr int DM = 1024, NB = 8, SEQ = 2048, M = NB * SEQ, DEPTH = 2;
constexpr int DIN = 3072, DFF = 4096, WB = 512, NGATE = 4096;
constexpr float EPS = 1e-6f;
typedef unsigned short bf16;
constexpr size_t MiB = 1u << 20;
constexpr size_t WS_CTL = 0, CTL_ZERO_BYTES = 1 * MiB;
constexpr size_t WS_MOD = 1 * MiB;
constexpr size_t WS_RS = 1 * MiB + 512 * 1024;
constexpr size_t WS_WIN = 2 * MiB, WS_WG = 8 * MiB, WS_WB = 16 * MiB, WS_WO = 20 * MiB, WS_W1 = 22 * MiB, WS_W2 = 30 * MiB, WS_WGLU = 38 * MiB;
constexpr size_t WS_H = 40 * MiB;
constexpr size_t WS_ZA = 72 * MiB, WS_ZC = 104 * MiB, WS_ZB = 136 * MiB;
constexpr size_t WS_GATES = 72 * MiB;
constexpr size_t WS_MERGED = 136 * MiB;
constexpr size_t WS_YS = 168 * MiB;
constexpr size_t WS_YSSM = 232 * MiB;
constexpr size_t WS_F1 = 72 * MiB;
constexpr size_t WS_END = 250 * MiB;
constexpr int CW_BAR = 4096;
constexpr int RING_OFF = 0, RING_BYTES = 131072;
constexpr int AUX_OFF = RING_BYTES, AUX_BYTES = 24576;
constexpr int LDSCTL_OFF = AUX_OFF + AUX_BYTES, MISC_OFF = LDSCTL_OFF + 320;
constexpr int LDS_BYTES = 163840;
#define GAS __attribute__((address_space(1)))
#define LAS __attribute__((address_space(3)))
typedef unsigned v4u __attribute__((ext_vector_type(4)));
typedef float f32x4 __attribute__((ext_vector_type(4)));
typedef GAS unsigned gu32;
#define LDS_WAIT() asm volatile("s_waitcnt lgkmcnt(0)" ::: "memory")
#define VM_WAIT() asm volatile("s_waitcnt vmcnt(0)" ::: "memory")
__device__ __forceinline__ unsigned f2bf(float f) { unsigned u = __builtin_bit_cast(unsigned, f); return (u + 0x7fffu + ((u >> 16) & 1u)) >> 16; }
__device__ __forceinline__ unsigned pk2(float lo, float hi) { return f2bf(lo) | (f2bf(hi) << 16); }
__device__ __forceinline__ float bf2f(bf16 h) { return __builtin_bit_cast(float, (unsigned)h << 16); }
#define XB_TMO      128
#define XB_XCNT(j)  (256  + 64 * (j))
#define XB_XSUB(j)  (1280 + 64 * (j))
#define XB_XGEN(j)  (2304 + 64 * (j))
#define XB_TOP      3328
#define XB_TOPGEN   3392
#define XCD_BAR_WORDS 3456
#define XB_SPIN_CAP (1u << 18)

__device__ __forceinline__ unsigned xb_ld(unsigned* p)              { return __hip_atomic_load(p, __ATOMIC_RELAXED, __HIP_MEMORY_SCOPE_AGENT); }
__device__ __forceinline__ unsigned xb_add(unsigned* p, unsigned v) { return __hip_atomic_fetch_add(p, v, __ATOMIC_RELAXED, __HIP_MEMORY_SCOPE_AGENT); }
__device__ __forceinline__ unsigned xb_xcc_id() { return (unsigned)__builtin_amdgcn_s_getreg((3 << 11) | 20) & 0xFu; }
#define XB_SPIN(cond, bar) do { unsigned _sp = 0; while (cond) { __builtin_amdgcn_s_sleep(1); \
    if ((++_sp & 255u) == 0u) { if (xb_ld(&(bar)[XB_TMO])) break; if (_sp > XB_SPIN_CAP) { atomicAdd(&(bar)[XB_TMO], 1u); break; } } } } while (0)

struct XcdBarrier {
    unsigned* bar; unsigned x;
    volatile LAS unsigned* st;
};

__device__ __forceinline__ XcdBarrier xcd_barrier_post(unsigned* bar, volatile LAS unsigned* st) {
    XcdBarrier b; b.bar = bar; b.x = xb_xcc_id(); b.st = st;
    if (threadIdx.x == 0) (void)xb_add(&bar[XB_XCNT(b.x)], 1u);
    return b;
}
__device__ __forceinline__ void xcd_barrier_complete(unsigned* bar, unsigned x, unsigned& nloc, unsigned& nx) {
    const unsigned G = gridDim.x * gridDim.y * gridDim.z;
    unsigned sum, cnt, mine, sp = 0u;
    for (;;) {
        sum = 0u; cnt = 0u; mine = 0u;
#pragma unroll
        for (unsigned j = 0; j < 16; ++j) { const unsigned c = xb_ld(&bar[XB_XCNT(j)]); sum += c; cnt += (c > 0u) ? 1u : 0u; mine = (j == x) ? c : mine; }
        if (sum == G) break;
        __builtin_amdgcn_s_sleep(1);
        if ((++sp & 255u) == 0u) { if (xb_ld(&bar[XB_TMO])) break; if (sp > XB_SPIN_CAP) { atomicAdd(&bar[XB_TMO], 1u); break; } }
    }
    nloc = mine > 0u ? mine : 1u; nx = cnt > 0u ? cnt : 1u;
}

__device__ __forceinline__ void xcd_barrier(const XcdBarrier& b) {
    asm volatile("s_waitcnt vmcnt(0)" ::: "memory");
    __syncthreads();
    if (threadIdx.x == 0) {
        unsigned* bar = b.bar;
        __builtin_amdgcn_s_waitcnt(0);
        unsigned nloc = b.st[0], nx = b.st[1];
        if (nloc == 0u) { xcd_barrier_complete(bar, b.x, nloc, nx); b.st[0] = nloc; b.st[1] = nx; }
        const unsigned old = xb_add(&bar[XB_XSUB(b.x)], 1u);
        const unsigned gen = old / nloc;
        if (old + 1u == (gen + 1u) * nloc) {
            __builtin_amdgcn_fence(__ATOMIC_RELEASE, "agent");
            asm volatile("s_waitcnt vmcnt(0)" ::: "memory");
            const unsigned og = xb_add(&bar[XB_TOP], 1u);
            const unsigned tg = og / nx;
            if (og + 1u == (tg + 1u) * nx) xb_add(&bar[XB_TOPGEN], 1u);
            else XB_SPIN(xb_ld(&bar[XB_TOPGEN]) == tg, bar);
            __builtin_amdgcn_fence(__ATOMIC_ACQUIRE, "agent");
            xb_add(&bar[XB_XGEN(b.x)], 1u);
            asm volatile("s_waitcnt vmcnt(0)" ::: "memory");
        } else {
            XB_SPIN(xb_ld(&bar[XB_XGEN(b.x)]) == gen, bar);
            __builtin_amdgcn_fence(__ATOMIC_ACQUIRE, "agent");
            asm volatile("s_waitcnt vmcnt(0)" ::: "memory");
        }
    }
    __syncthreads();
}

struct Frame {
    LAS unsigned char* lds;
    volatile LAS unsigned* MISC;
    gu32* ctl;
    int tid, lane, wave, vcu, G;
};
__device__ __forceinline__ float wave_sum(float v) {
#pragma unroll
    for (int o = 1; o < 64; o <<= 1) v += __shfl_xor(v, o);
    return v;
}
__device__ __forceinline__ void transpose_item(const float* W, int N, bf16* WT, int ldt, int koff, LAS float* scr, int item, int lane) {
    const int nblk = N / 32, kb = item / nblk, nb = item % nblk, k0 = 64 * kb, n0 = 32 * nb;
#pragma unroll 8
    for (int i = 0; i < 32; ++i) { const int kk = 2 * i + (lane >> 5); scr[kk * 33 + (lane & 31)] = W[(size_t)(k0 + kk) * N + n0 + (lane & 31)]; }
    LDS_WAIT(); asm volatile("" ::: "memory");
    const int c = lane & 7;
#pragma unroll
    for (int j = 0; j < 4; ++j) { const int n = (lane >> 3) + 8 * j; const LAS float* s = scr + (8 * c) * 33 + n;
        v4u o; o.x = pk2(s[0 * 33], s[1 * 33]); o.y = pk2(s[2 * 33], s[3 * 33]); o.z = pk2(s[4 * 33], s[5 * 33]); o.w = pk2(s[6 * 33], s[7 * 33]);
        *(GAS v4u*)(WT + (size_t)(n0 + n) * ldt + koff + k0 + 8 * c) = o; }
    LDS_WAIT(); asm volatile("" ::: "memory");
}
__device__ __forceinline__ int opq_blk() { int c = blockIdx.x; asm volatile("" : "+s"(c)); return c; }
template <class T> __device__ __forceinline__ T* opq(T* p) { asm volatile("" : "+s"(p)); return p; }
__device__ __forceinline__ int opq_lane() { int l = threadIdx.x & 63; asm volatile("" : "+v"(l)); return l; }
struct Args { const float* in[36]; float* out; unsigned char* ws; int ph_lo, ph_hi, li, pad; };

__device__ __forceinline__ void convert_weights(Frame& F, const Args& a, int l) {
    const int lane = opq_lane();
    LAS float* scr = (LAS float*)(F.lds + RING_OFF + F.wave * 16384);
    const int gw = F.vcu * NWAVES + F.wave, NGW = F.G * NWAVES;
    unsigned char* ws = a.ws;
    constexpr int I_IN = 16 * 96, I_G = 16 * 128, I_B = 8 * 32, I_O = 16 * 32, I_1 = 16 * 128, I_2 = 64 * 32, I_GLU = 8 * 16;
    constexpr int NITEMS = I_IN + I_G + 4 * I_B + I_O + I_1 + I_2 + I_GLU;
    for (int it = gw; it < NITEMS; it += NGW) {
        int r = it;
        if (r < I_IN) { transpose_item(a.in[5] + (size_t)l * DM * DIN, DIN, (bf16*)(ws + WS_WIN), DM, 0, scr, r, lane); continue; } r -= I_IN;
        if (r < I_G) { transpose_item(a.in[29] + (size_t)l * DM * NGATE, NGATE, (bf16*)(ws + WS_WG), DM, 0, scr, r, lane); continue; } r -= I_G;
        if (r < 4 * I_B) { const int k = r / I_B; if (k > 0) transpose_item(a.in[28] + ((size_t)l * 4 + k) * WB * DM, DM, (bf16*)(ws + WS_WB), 4 * WB, k * WB, scr, r % I_B, lane); continue; } r -= 4 * I_B;
        if (r < I_O) { transpose_item(a.in[31] + (size_t)l * DM * DM, DM, (bf16*)(ws + WS_WO), DM, 0, scr, r, lane); continue; } r -= I_O;
        if (r < I_1) { transpose_item(a.in[33] + (size_t)l * DM * DFF, DFF, (bf16*)(ws + WS_W1), DM, 0, scr, r, lane); continue; } r -= I_1;
        if (r < I_2) { transpose_item(a.in[34] + (size_t)l * DFF * DM, DM, (bf16*)(ws + WS_W2), DFF, 0, scr, r, lane); continue; } r -= I_2;
        transpose_item(a.in[16] + (size_t)l * WB * WB, WB, (bf16*)(ws + WS_WGLU), WB, 0, scr, r, lane);
    }
}
__device__ __forceinline__ void normmod_rows(Frame& F, const float* x, const float* g, const float* sc, const float* sh, bf16* out) {
    const int lane = opq_lane();
    const int gw = F.vcu * NWAVES + F.wave, NGW = F.G * NWAVES;
    for (int m = gw; m < M; m += NGW) {
        const int b = m / SEQ;
        const GAS f32x4* xr = (const GAS f32x4*)(x + (size_t)m * DM) + lane;
        f32x4 v[4]; float s = 0.f;
#pragma unroll
        for (int j = 0; j < 4; ++j) { v[j] = xr[64 * j]; s += (v[j].x * v[j].x + v[j].y * v[j].y) + (v[j].z * v[j].z + v[j].w * v[j].w); }
        const float r = 1.0f / sqrtf(wave_sum(s) * (1.f / DM) + EPS);
        GAS unsigned long long* o8 = (GAS unsigned long long*)(out + (size_t)m * DM) + lane;
#pragma unroll
        for (int j = 0; j < 4; ++j) { const f32x4 gg = ((const GAS f32x4*)g)[lane + 64 * j], s1 = ((const GAS f32x4*)(sc + (size_t)b * 6 * DM))[lane + 64 * j], s0 = ((const GAS f32x4*)(sh + (size_t)b * 6 * DM))[lane + 64 * j];
            const f32x4 o = v[j] * r * gg * (1.0f + s1) + s0;
            o8[64 * j] = (unsigned long long)pk2(o.x, o.y) | ((unsigned long long)pk2(o.z, o.w) << 32); }
    }
}
__device__ __forceinline__ void final_rows(Frame& F, float* x, const float* g) {
    const int lane = opq_lane();
    const int gw = F.vcu * NWAVES + F.wave, NGW = F.G * NWAVES;
    for (int m = gw; m < M; m += NGW) {
        GAS f32x4* xr = (GAS f32x4*)(x + (size_t)m * DM) + lane;
        f32x4 v[4]; float s = 0.f;
#pragma unroll
        for (int j = 0; j < 4; ++j) { v[j] = xr[64 * j]; s += (v[j].x * v[j].x + v[j].y * v[j].y) + (v[j].z * v[j].z + v[j].w * v[j].w); }
        const float r = 1.0f / sqrtf(wave_sum(s) * (1.f / DM) + EPS);
#pragma unroll
        for (int j = 0; j < 4; ++j) xr[64 * j] = v[j] * r * ((const GAS f32x4*)g)[lane + 64 * j];
    }
}

typedef short bf16x8 __attribute__((ext_vector_type(8)));
typedef float f32x16 __attribute__((ext_vector_type(16)));
constexpr size_t WS_GWS = 38 * MiB + 512 * 1024;
__device__ __forceinline__ float sigmoid_acc(float x) { return 1.f / (1.f + expf(-x)); }
__device__ __forceinline__ float gelu_acc(float x) { const float u = 0.7978845608028654f * (x + 0.044715f * x * x * x); return x / (1.f + expf(-2.f * u)); }

__device__ __forceinline__ void ada_phase(Frame& F, const float* c, const float* ada_w, const float* ada_b, float* mod) {
    LAS float* sc = (LAS float*)(F.lds);
    LAS float* red = (LAS float*)(F.lds + 32768);
    const int tid = opq_lane() + 64 * F.wave;
    for (int e = tid; e < NB * DM; e += NWAVES * 64) { const int b = e >> 10, k = e & 1023; const float v = c[e]; sc[k * 8 + b] = v / (1.f + expf(-v)); }
    __syncthreads();
    for (int cb = blockIdx.x; cb < 256; cb += F.G) {
        const int cl = tid % 48, ks = tid / 48, colg = cb * 48 + cl, l = colg / (6 * DM), j = colg % (6 * DM);
        if (tid < 384) {
            float acc[8];
#pragma unroll
            for (int b = 0; b < 8; ++b) acc[b] = 0.f;
            const float* w = ada_w + ((size_t)l * DM + ks * 128) * 6 * DM + j;
#pragma unroll 4
            for (int k = 0; k < 128; ++k) { const float wv = w[(size_t)k * 6 * DM]; const LAS f32x4* s4 = (const LAS f32x4*)(sc + (ks * 128 + k) * 8); const f32x4 s0 = s4[0], s1 = s4[1];
                acc[0] = fmaf(s0.x, wv, acc[0]); acc[1] = fmaf(s0.y, wv, acc[1]); acc[2] = fmaf(s0.z, wv, acc[2]); acc[3] = fmaf(s0.w, wv, acc[3]);
                acc[4] = fmaf(s1.x, wv, acc[4]); acc[5] = fmaf(s1.y, wv, acc[5]); acc[6] = fmaf(s1.z, wv, acc[6]); acc[7] = fmaf(s1.w, wv, acc[7]); }
#pragma unroll
            for (int b = 0; b < 8; ++b) red[(ks * 8 + b) * 48 + cl] = acc[b];
        }
        __syncthreads();
        if (tid < 384) { const int b = tid / 48; float s = ada_b[l * 6 * DM + j];
#pragma unroll
            for (int k2 = 0; k2 < 8; ++k2) s += red[(k2 * 8 + b) * 48 + cl];
            mod[((size_t)l * NB + b) * 6 * DM + j] = s; }
        __syncthreads();
    }
}
__device__ __forceinline__ void small_weights(Frame& F, const Args& a, int l) {
    const int gt = F.vcu * (NWAVES * 64) + F.wave * 64 + opq_lane(), NT = F.G * NWAVES * 64;
    const float* pw = a.in[6] + (size_t)l * 4 * 128 * 128; const float* ps = a.in[7] + l * WB; const float* wb0 = a.in[28] + (size_t)l * 4 * WB * DM;
    bf16* WbT = (bf16*)(a.ws + WS_WB);
    for (int it = gt; it < 64 * 1024; it += NT) {
        const int n = it & 1023, c8 = it >> 10, g = c8 >> 4, c0 = (c8 & 15) * 8;
        float acc[8];
#pragma unroll
        for (int i = 0; i < 8; ++i) acc[i] = 0.f;
        for (int d = 0; d < 128; ++d) { const float wv = wb0[(size_t)(g * 128 + d) * DM + n] * ps[g * 128 + d];
#pragma unroll
            for (int i = 0; i < 8; ++i) acc[i] = fmaf(pw[(size_t)(g * 128 + c0 + i) * 128 + d], wv, acc[i]); }
        v4u o; o.x = pk2(acc[0], acc[1]); o.y = pk2(acc[2], acc[3]); o.z = pk2(acc[4], acc[5]); o.w = pk2(acc[6], acc[7]);
        *(GAS v4u*)(WbT + (size_t)n * (4 * WB) + c8 * 8) = o;
    }
    const float* gws = a.in[26] + (size_t)l * 4 * 128 * 128; bf16* G = (bf16*)(a.ws + WS_GWS);
    for (int it = gt; it < 4 * 128 * 128 / 2; it += NT) ((GAS unsigned*)G)[it] = pk2(gws[2 * it], gws[2 * it + 1]);
}
__device__ __forceinline__ void pool_phase(Frame& F, const unsigned char* ws) {
    const int gt = F.vcu * (NWAVES * 64) + F.wave * 64 + opq_lane(), NT = F.G * NWAVES * 64;
    const bf16* ZA = (const bf16*)(ws + WS_ZA); bf16* YS = (bf16*)(ws + WS_YS);
    for (int it = gt; it < M * 64; it += NT) {
        const int c8 = it & 63, m = it >> 6, t = m & (SEQ - 1), g = c8 >> 4, w = 2 << g;
        int lo = t - w / 2, hi = lo + w; lo = lo < 0 ? 0 : lo; hi = hi > SEQ ? SEQ : hi;
        float s[8];
#pragma unroll
        for (int i = 0; i < 8; ++i) s[i] = 0.f;
        const bf16* base = ZA + (size_t)(m - t) * DM + c8 * 8;
        for (int q = lo; q < hi; ++q) { const v4u r = *(const GAS v4u*)(base + (size_t)q * DM);
            s[0] += pg8::bf_lo(r.x); s[1] += pg8::bf_hi(r.x); s[2] += pg8::bf_lo(r.y); s[3] += pg8::bf_hi(r.y); s[4] += pg8::bf_lo(r.z); s[5] += pg8::bf_hi(r.z); s[6] += pg8::bf_lo(r.w); s[7] += pg8::bf_hi(r.w); }
        const v4u cz = *(const GAS v4u*)(base + (size_t)t * DM); const float inv = 1.f / (float)(hi - lo);
        v4u o; o.x = pk2(s[0] * inv - pg8::bf_lo(cz.x), s[1] * inv - pg8::bf_hi(cz.x)); o.y = pk2(s[2] * inv - pg8::bf_lo(cz.y), s[3] * inv - pg8::bf_hi(cz.y));
        o.z = pk2(s[4] * inv - pg8::bf_lo(cz.z), s[5] * inv - pg8::bf_hi(cz.z)); o.w = pk2(s[6] * inv - pg8::bf_lo(cz.w), s[7] * inv - pg8::bf_hi(cz.w));
        *(GAS v4u*)(YS + (size_t)m * (4 * WB) + c8 * 8) = o;
    }
}
__device__ __forceinline__ void gmlp_phase(Frame& F, const Args& a, int l) {
    const unsigned char* ws = a.ws;
    const bf16* ZC = (const bf16*)(ws + WS_ZC); bf16* YS = (bf16*)(ws + WS_YS); const bf16* GW = (const bf16*)(ws + WS_GWS);
    const float* ng = a.in[25] + l * WB; const float* bs = a.in[27] + l * 4 * 128;
    LAS float* rs = (LAS float*)(F.lds); LAS bf16* vnT = (LAS bf16*)(F.lds + 1024);
    const int lane = opq_lane(), w = F.wave, tid = w * 64 + lane;
    for (int unit = blockIdx.x; unit < 128 * 4; unit += F.G) {
        const int g = unit & 3, tok0 = (unit >> 2) * 128;
#pragma unroll 4
        for (int i = 0; i < 16; ++i) { const int p = w * 16 + i; const v4u r = *(const GAS v4u*)(ZC + (size_t)(tok0 + p) * DM + 512 + lane * 8);
            float s = pg8::bf_lo(r.x) * pg8::bf_lo(r.x) + pg8::bf_hi(r.x) * pg8::bf_hi(r.x) + pg8::bf_lo(r.y) * pg8::bf_lo(r.y) + pg8::bf_hi(r.y) * pg8::bf_hi(r.y)
                    + pg8::bf_lo(r.z) * pg8::bf_lo(r.z) + pg8::bf_hi(r.z) * pg8::bf_hi(r.z) + pg8::bf_lo(r.w) * pg8::bf_lo(r.w) + pg8::bf_hi(r.w) * pg8::bf_hi(r.w);
            s = wave_sum(s); if (lane == 0) rs[p] = 1.0f / sqrtf(s * (1.f / WB) + EPS); }
        __syncthreads();
#pragma unroll
        for (int e = tid; e < 2048; e += NWAVES * 64) { const int cc = e >> 7, p = e & 127;
            const v4u r = *(const GAS v4u*)(ZC + (size_t)(tok0 + p) * DM + 512 + g * 128 + cc * 8); const float sc = rs[p];
            const f32x4 g0 = *(const GAS f32x4*)(ng + g * 128 + cc * 8), g1 = *(const GAS f32x4*)(ng + g * 128 + cc * 8 + 4);
            LAS bf16* d = vnT + (cc * 8) * 136 + p;
            d[0 * 136] = (bf16)f2bf(pg8::bf_lo(r.x) * sc * g0.x); d[1 * 136] = (bf16)f2bf(pg8::bf_hi(r.x) * sc * g0.y); d[2 * 136] = (bf16)f2bf(pg8::bf_lo(r.y) * sc * g0.z); d[3 * 136] = (bf16)f2bf(pg8::bf_hi(r.y) * sc * g0.w);
            d[4 * 136] = (bf16)f2bf(pg8::bf_lo(r.z) * sc * g1.x); d[5 * 136] = (bf16)f2bf(pg8::bf_hi(r.z) * sc * g1.y); d[6 * 136] = (bf16)f2bf(pg8::bf_lo(r.w) * sc * g1.z); d[7 * 136] = (bf16)f2bf(pg8::bf_hi(r.w) * sc * g1.w); }
        __syncthreads();
        const int qt = w & 3, ch = w >> 2, lr = lane & 31, lh = lane >> 5;
        f32x16 acc0, acc1;
#pragma unroll
        for (int i = 0; i < 16; ++i) { acc0[i] = 0.f; acc1[i] = 0.f; }
        const bf16* arow = GW + ((size_t)g * 128 + qt * 32 + lr) * 128 + lh * 8;
        const LAS bf16* b0 = vnT + (ch * 64 + lr) * 136 + lh * 8; const LAS bf16* b1 = b0 + 32 * 136;
#pragma unroll
        for (int ks = 0; ks < 8; ++ks) { const bf16x8 av = *(const GAS bf16x8*)(arow + ks * 16); const bf16x8 bv0 = *(const LAS bf16x8*)(b0 + ks * 16), bv1 = *(const LAS bf16x8*)(b1 + ks * 16);
            acc0 = __builtin_amdgcn_mfma_f32_32x32x16_bf16(av, bv0, acc0, 0, 0, 0); acc1 = __builtin_amdgcn_mfma_f32_32x32x16_bf16(av, bv1, acc1, 0, 0, 0); }
#pragma unroll
        for (int r = 0; r < 16; ++r) { const int q = qt * 32 + (r & 3) + 8 * (r >> 2) + 4 * lh; const float bq = bs[g * 128 + q]; const size_t tk = (size_t)(tok0 + q);
            const int c0 = g * 128 + ch * 64 + lr;
            const float u0 = bf2f(ZC[tk * DM + c0]), u1 = bf2f(ZC[tk * DM + c0 + 32]);
            YS[tk * (4 * WB) + 3 * WB + c0] = (bf16)f2bf(u0 * (acc0[r] + bq)); YS[tk * (4 * WB) + 3 * WB + c0 + 32] = (bf16)f2bf(u1 * (acc1[r] + bq)); }
        __syncthreads();
    }
}
__device__ __forceinline__ void ssm_wave_naive(Frame& F, const Args& a, int l, int unit, LAS float* red  ) {
    const unsigned char* ws = a.ws; const bf16* ZA = (const bf16*)(ws + WS_ZA); bf16* YSSM = (bf16*)(ws + WS_YSSM);
    const int b = unit >> 5, g = unit & 31, p = opq_lane(), hh = p & 15, q = p >> 4;
    const float dsk = a.in[15][l * WB + g * 16 + hh];
#pragma unroll 1
    for (int dir = 0; dir < 2; ++dir) {
        const float lr = a.in[8][((l * 2 + dir) * 32 + g) * 64 + p], li = a.in[9][((l * 2 + dir) * 32 + g) * 64 + p], dt = expf(a.in[10][(l * 2 + dir) * 32 + g]);
        const float mag = expf(lr * dt), are = mag * cosf(li * dt), aim = mag * sinf(li * dt);
        const float den = lr * lr + li * li, nr = are - 1.f, fre = (nr * lr + aim * li) / den, fim = (aim * lr - nr * li) / den;
        float bbr[16], bbi[16], cr[16], ci[16];
#pragma unroll
        for (int h = 0; h < 16; ++h) { const float br = a.in[11][((size_t)(l * 32 + g) * 64 + p) * 16 + h], bi = a.in[12][((size_t)(l * 32 + g) * 64 + p) * 16 + h]; bbr[h] = fre * br - fim * bi; bbi[h] = fre * bi + fim * br;
            cr[h] = a.in[13][(((size_t)(l * 2 + dir) * 32 + g) * 16 + h) * 64 + p]; ci[h] = a.in[14][(((size_t)(l * 2 + dir) * 32 + g) * 16 + h) * 64 + p]; }
        float hre = 0.f, him = 0.f;
#pragma unroll 1
        for (int step = 0; step < SEQ; ++step) {
            const int t = dir ? SEQ - 1 - step : step; const size_t m = (size_t)b * SEQ + t;
            const bf16* zp = ZA + m * DM + 512 + g * 16;
            const v4u r0 = *(const GAS v4u*)zp, r1 = *(const GAS v4u*)(zp + 8);
            float u[16] = {pg8::bf_lo(r0.x), pg8::bf_hi(r0.x), pg8::bf_lo(r0.y), pg8::bf_hi(r0.y), pg8::bf_lo(r0.z), pg8::bf_hi(r0.z), pg8::bf_lo(r0.w), pg8::bf_hi(r0.w),
                           pg8::bf_lo(r1.x), pg8::bf_hi(r1.x), pg8::bf_lo(r1.y), pg8::bf_hi(r1.y), pg8::bf_lo(r1.z), pg8::bf_hi(r1.z), pg8::bf_lo(r1.w), pg8::bf_hi(r1.w)};
            float xre = 0.f, xim = 0.f;
#pragma unroll
            for (int h = 0; h < 16; ++h) { xre = fmaf(bbr[h], u[h], xre); xim = fmaf(bbi[h], u[h], xim); }
            const float nre = are * hre - aim * him + xre, nim = are * him + aim * hre + xim; hre = nre; him = nim;
#pragma unroll
            for (int h = 0; h < 16; ++h) red[h * 65 + p] = cr[h] * hre - ci[h] * him;
            asm volatile("s_waitcnt lgkmcnt(0)" ::: "memory");
            float s = 0.f;
#pragma unroll
            for (int k = 0; k < 16; ++k) s += red[hh * 65 + q * 16 + k];
            asm volatile("s_waitcnt lgkmcnt(0)" ::: "memory");
            s += __shfl_xor(s, 16); s += __shfl_xor(s, 32);
            if (p < 16) {
                if (dir == 0) YSSM[m * WB + g * 16 + hh] = (bf16)f2bf(dsk * bf2f(zp[hh]) + s);
                else YSSM[m * WB + g * 16 + hh] = (bf16)f2bf(gelu_acc(bf2f(YSSM[m * WB + g * 16 + hh]) + s));
            }
        }
    }
}
__device__ __forceinline__ void lru_wave_naive(Frame& F, const Args& a, int l, int unit, LAS float* xcs  ) {
    const unsigned char* ws = a.ws; const bf16* ZB = (const bf16*)(ws + WS_ZB); bf16* YS = (bf16*)(ws + WS_YS);
    const int b = unit >> 3, k = unit & 7, d = opq_lane(), ch = k * 64 + d;
    const float* cw = a.in[18] + l * 4 * WB; const float cw0 = cw[0 * WB + ch], cw1 = cw[1 * WB + ch], cw2 = cw[2 * WB + ch], cw3 = cw[3 * WB + ch], cb = a.in[19][l * WB + ch];
#pragma unroll 1
    for (int dir = 0; dir < 2; ++dir) {
        const float lamv = a.in[24][(l * 2 + dir) * WB + ch], ls = -log1pf(expf(-lamv));
        const float bav = a.in[21][(l * 2 + dir) * WB + ch], bxv = a.in[23][(l * 2 + dir) * WB + ch];
        const float* wa = a.in[20] + ((size_t)(l * 2 + dir) * 8 + k) * 64 * 64; const float* wx = a.in[22] + ((size_t)(l * 2 + dir) * 8 + k) * 64 * 64;
        float war[64], wxr[64];
#pragma unroll
        for (int c = 0; c < 64; ++c) { war[c] = wa[c * 64 + d]; wxr[c] = wx[c * 64 + d]; }
        float h = 0.f;
#pragma unroll 1
        for (int step = 0; step < SEQ; ++step) {
            const int t = dir ? SEQ - 1 - step : step; const size_t m = (size_t)b * SEQ + t;
            const bf16* zr = ZB + m * DM + ch;
            float xc = cb + cw2 * bf2f(zr[0]);
            if (t >= 2) xc += cw0 * bf2f(zr[-2 * DM]);
            if (t >= 1) xc += cw1 * bf2f(zr[-1 * DM]);
            if (t + 1 < SEQ) xc += cw3 * bf2f(zr[DM]);
            xcs[d] = xc;
            asm volatile("s_waitcnt lgkmcnt(0)" ::: "memory");
            float rp = bav, ip = bxv;
#pragma unroll
            for (int c = 0; c < 64; ++c) { const float xv = xcs[c]; rp = fmaf(xv, war[c], rp); ip = fmaf(xv, wxr[c], ip); }
            asm volatile("s_waitcnt lgkmcnt(0)" ::: "memory");
            const float r = sigmoid_acc(rp), ig = sigmoid_acc(ip), loga = 8.f * r * ls, av = expf(loga), mult = sqrtf(-expm1f(2.f * loga));
            h = av * h + mult * ig * xc;
            if (dir == 0) YS[m * (4 * WB) + 2 * WB + ch] = (bf16)f2bf(h);
            else YS[m * (4 * WB) + 2 * WB + ch] = (bf16)f2bf((bf2f(YS[m * (4 * WB) + 2 * WB + ch]) + h) * bf2f(zr[512]));
        }
    }
}
__device__ __forceinline__ float dpp_swap1(float v) { return __builtin_bit_cast(float, __builtin_amdgcn_mov_dpp(__builtin_bit_cast(int, v), 0xB1, 0xF, 0xF, true)); }
typedef float f32x4v __attribute__((ext_vector_type(4)));
constexpr int SSM_ROW = 272;
__device__ __forceinline__ void ssm_unit(Frame& F, const Args& a, int l, int unit) {
    const unsigned char* ws = a.ws; const bf16* ZA = (const bf16*)(ws + WS_ZA); bf16* YSSM = (bf16*)(ws + WS_YSSM);
    const int b = unit >> 5, g = unit & 31, lane = opq_lane(), w = F.wave;
    LAS float* Yacc = (LAS float*)(F.lds);
    LAS unsigned char* Himg = F.lds + AUX_OFF;
    const size_t zrow0 = (size_t)b * SEQ;
    float A1c = 0.f, A2c = 0.f, hst = 0.f, dsk = 0.f; bf16x8 B1 = {0, 0, 0, 0, 0, 0, 0, 0}, B2 = B1; bf16x8 Cf[4]; Cf[0] = B1; Cf[1] = B1; Cf[2] = B1; Cf[3] = B1;
    const int n = lane & 31, hh = lane >> 5;
    const int r_hD = (n >> 2) & 1, r_i = (n & 3) + 4 * (n >> 3);
    const bf16* ubase = ZA + zrow0 * DM + 512 + g * 16 + 8 * hh;
    v4u un = {0u, 0u, 0u, 0u};
    if (w < 4) {
        const int p = 16 * w + (n >> 1), c = n & 1;
        float are[2], aim[2], fre[2], fim[2];
#pragma unroll
        for (int d = 0; d < 2; ++d) { const float lr = a.in[8][((l * 2 + d) * 32 + g) * 64 + p], li = a.in[9][((l * 2 + d) * 32 + g) * 64 + p], dt = expf(a.in[10][(l * 2 + d) * 32 + g]);
            const float mag = expf(lr * dt); are[d] = mag * cosf(li * dt); aim[d] = mag * sinf(li * dt);
            const float den = lr * lr + li * li, nr = are[d] - 1.f; fre[d] = (nr * lr + aim[d] * li) / den; fim[d] = (aim[d] * lr - nr * li) / den; }
        const float* brp = a.in[11] + ((size_t)(l * 32 + g) * 64 + p) * 16 + 8 * hh; const float* bip = a.in[12] + ((size_t)(l * 32 + g) * 64 + p) * 16 + 8 * hh;
#pragma unroll
        for (int j = 0; j < 8; ++j) { const float br = brp[j], bi = bip[j];
            const float v1 = c ? (fre[0] * bi + fim[0] * br) : (fre[0] * br - fim[0] * bi), v2 = c ? (fre[1] * bi + fim[1] * br) : (fre[1] * br - fim[1] * bi);
            B1[j] = (short)f2bf(v1); B2[j] = (short)f2bf(v2); }
        A1c = hh ? are[1] : are[0]; const float ai = hh ? aim[1] : aim[0]; A2c = c ? ai : -ai;
        un = *(const GAS v4u*)(ubase + (size_t)(r_hD ? SEQ - 1 - r_i : r_i) * DM);
    } else if (w < 6) {
        const int dir = w - 4, h = lane & 15, kq = lane >> 4;
        dsk = a.in[15][l * WB + g * 16 + h];
        const float* crp = a.in[13] + (((size_t)(l * 2 + dir) * 32 + g) * 16 + h) * 64; const float* cip = a.in[14] + (((size_t)(l * 2 + dir) * 32 + g) * 16 + h) * 64;
#pragma unroll
        for (int ks = 0; ks < 4; ++ks)
#pragma unroll
            for (int j = 0; j < 8; ++j) { const int kap = 32 * ks + 8 * kq + j, p = kap >> 1; Cf[ks][j] = (short)f2bf((kap & 1) ? -cip[p] : crp[p]); }
    }
#pragma unroll 1
    for (int s = 0; s <= 128; ++s) {
        if (w < 4) {
            if (s < 128) {
                const v4u uc = un;
                if (s + 1 < 128) un = *(const GAS v4u*)(ubase + (size_t)(r_hD ? SEQ - 1 - (16 * (s + 1) + r_i) : 16 * (s + 1) + r_i) * DM);
                const v4u z4 = {0u, 0u, 0u, 0u};
                const bf16x8 Af = __builtin_bit_cast(bf16x8, r_hD ? z4 : uc), Ab = __builtin_bit_cast(bf16x8, r_hD ? uc : z4);
                f32x16 x;
#pragma unroll
                for (int i = 0; i < 16; ++i) x[i] = 0.f;
                x = __builtin_amdgcn_mfma_f32_32x32x16_bf16(Af, B1, x, 0, 0, 0);
                x = __builtin_amdgcn_mfma_f32_32x32x16_bf16(Ab, B2, x, 0, 0, 0);
                LAS unsigned char* hrow = Himg + ((s & 1) * 2 + hh) * 16 * SSM_ROW + (32 * w + n) * 2;
#pragma unroll
                for (int i = 0; i < 16; ++i) { const float hp = dpp_swap1(hst); hst = fmaf(A1c, hst, fmaf(A2c, hp, x[i])); *(LAS bf16*)(hrow + i * SSM_ROW) = (bf16)f2bf(hst); }
            }
        } else if (w < 6) {
            if (s >= 1) {
                const int sp = s - 1, dir = w - 4, h = lane & 15, q4 = lane >> 4;
                const LAS unsigned char* arow = Himg + ((sp & 1) * 2 + dir) * 16 * SSM_ROW + (lane & 15) * SSM_ROW + 16 * q4;
                f32x4v acc = {0.f, 0.f, 0.f, 0.f};
#pragma unroll
                for (int ks = 0; ks < 4; ++ks) { const bf16x8 av = *(const LAS bf16x8*)(arow + 64 * ks); acc = __builtin_amdgcn_mfma_f32_16x16x32_bf16(av, Cf[ks], acc, 0, 0, 0); }
#pragma unroll
                for (int r = 0; r < 4; ++r) { const int i = 4 * q4 + r, tok = dir ? SEQ - 1 - (16 * sp + i) : 16 * sp + i;
                    if (sp < 64) Yacc[tok * 16 + h] = acc[r];
                    else { const float u = bf2f(ZA[(zrow0 + tok) * DM + 512 + g * 16 + h]); const float tot = Yacc[tok * 16 + h] + acc[r] + dsk * u;
                        YSSM[(zrow0 + tok) * WB + g * 16 + h] = (bf16)f2bf(pg8::gelu_tanh(tot)); } }
            }
        }
        __syncthreads();
    }
}
constexpr size_t WS_LRW = WS_GWS + 128 * 1024;
constexpr size_t WS_LSUM = 248 * MiB;
constexpr int LRU_ROW = 528;
__device__ __forceinline__ void lru_weights(Frame& F, const Args& a, int l) {
    const int gt = F.vcu * (NWAVES * 64) + F.wave * 64 + opq_lane(), NT = F.G * NWAVES * 64;
    bf16* LRW = (bf16*)(a.ws + WS_LRW);
    for (int it = gt; it < 2 * 2 * 8 * 64 * 8; it += NT) {
        const int c8 = it & 7, d = (it >> 3) & 63, k = (it >> 9) & 7, dir = (it >> 12) & 1, mat = it >> 13;
        const float* src = (mat ? a.in[22] : a.in[20]) + ((size_t)(l * 2 + dir) * 8 + k) * 64 * 64 + (size_t)(c8 * 8) * 64 + d;
        v4u o; o.x = pk2(src[0 * 64], src[1 * 64]); o.y = pk2(src[2 * 64], src[3 * 64]); o.z = pk2(src[4 * 64], src[5 * 64]); o.w = pk2(src[6 * 64], src[7 * 64]);
        *(GAS v4u*)(LRW + ((((size_t)mat * 2 + dir) * 8 + k) * 64 + d) * 64 + c8 * 8) = o;
    }
}
template <int PASS> __device__ __forceinline__ void lru_unit(Frame& F, const Args& a, int l, int unit) {
    const unsigned char* ws = a.ws; const bf16* ZB = (const bf16*)(ws + WS_ZB); bf16* YS = (bf16*)(ws + WS_YS); float* LSUM = (float*)(ws + WS_LSUM); const bf16* LRW = (const bf16*)(ws + WS_LRW);
    const int ch2 = unit & 1, cc = (unit >> 1) & 31, b = unit >> 6;
    const int lane = opq_lane(), w = F.wave, tid = w * 64 + lane;
    LAS unsigned char* xcI = F.lds;
    LAS float* hbuf = (LAS float*)(F.lds + 34816);
    const size_t m0 = (size_t)b * SEQ + cc * 64;
    { const float* cw = a.in[18] + l * 4 * WB; const float* cbp = a.in[19] + l * WB;
#pragma unroll
      for (int e = tid; e < 64 * 32; e += NWAVES * 64) { const int tl = e >> 5, c8 = e & 31, chg = ch2 * 256 + c8 * 8, t = cc * 64 + tl;
        float acc[8]; { const f32x4 c0 = *(const GAS f32x4*)(cbp + chg), c1 = *(const GAS f32x4*)(cbp + chg + 4); acc[0] = c0.x; acc[1] = c0.y; acc[2] = c0.z; acc[3] = c0.w; acc[4] = c1.x; acc[5] = c1.y; acc[6] = c1.z; acc[7] = c1.w; }
#pragma unroll
        for (int j = 0; j < 4; ++j) { const int tt = t + j - 2;
            if (tt >= 0 && tt < SEQ) { const v4u r = *(const GAS v4u*)(ZB + ((size_t)b * SEQ + tt) * DM + chg); const f32x4 w0 = *(const GAS f32x4*)(cw + j * WB + chg), w1 = *(const GAS f32x4*)(cw + j * WB + chg + 4);
                acc[0] = fmaf(w0.x, pg8::bf_lo(r.x), acc[0]); acc[1] = fmaf(w0.y, pg8::bf_hi(r.x), acc[1]); acc[2] = fmaf(w0.z, pg8::bf_lo(r.y), acc[2]); acc[3] = fmaf(w0.w, pg8::bf_hi(r.y), acc[3]);
                acc[4] = fmaf(w1.x, pg8::bf_lo(r.z), acc[4]); acc[5] = fmaf(w1.y, pg8::bf_hi(r.z), acc[5]); acc[6] = fmaf(w1.z, pg8::bf_lo(r.w), acc[6]); acc[7] = fmaf(w1.w, pg8::bf_hi(r.w), acc[7]); } }
        v4u o; o.x = pk2(acc[0], acc[1]); o.y = pk2(acc[2], acc[3]); o.z = pk2(acc[4], acc[5]); o.w = pk2(acc[6], acc[7]);
        *(LAS v4u*)(xcI + tl * LRU_ROW + c8 * 16) = o; } }
    __syncthreads();
    const int kl = w >> 1, n = lane & 31, hh = lane >> 5, dloc = 32 * (w & 1) + n, chl = 64 * kl + dloc, ch = ch2 * 256 + chl, kblk = ch2 * 4 + kl;
    const float bav = a.in[21][(l * 2 + hh) * WB + ch], bxv = a.in[23][(l * 2 + hh) * WB + ch];
    const float lamv = a.in[24][(l * 2 + hh) * WB + ch], ls8 = -8.0f * 1.4426950408889634f * log1pf(expf(-lamv));
    bf16x8 Br[8], Bi[8];
#pragma unroll
    for (int kp = 0; kp < 8; ++kp) { const int dir = kp >> 2;
        Br[kp] = *(const GAS bf16x8*)(LRW + ((((size_t)0 * 2 + dir) * 8 + kblk) * 64 + dloc) * 64 + 16 * (kp & 3) + 8 * hh);
        Bi[kp] = *(const GAS bf16x8*)(LRW + ((((size_t)1 * 2 + dir) * 8 + kblk) * 64 + dloc) * 64 + 16 * (kp & 3) + 8 * hh); }
    const int r_hD = (n >> 2) & 1, r_i = (n & 3) + 4 * (n >> 3);
    float h = 0.f, P = 1.f;
    if (PASS == 2) {
        const int steps = hh ? 31 - cc : cc, smax = cc > 31 - cc ? cc : 31 - cc;
        for (int it = 0; it < smax; ++it) { const int jc = hh ? 31 - it : it;
            if (it < steps) { const float2 s = *(const float2*)(LSUM + ((((size_t)b * 32 + jc) * 2 + hh) * WB + ch) * 2); h = fmaf(s.x, h, s.y); } }
    }
#pragma unroll 1
    for (int j = 0; j < 4; ++j) {
        const int tlA = r_hD ? 63 - (16 * j + r_i) : 16 * j + r_i;
        const LAS unsigned char* arow = xcI + tlA * LRU_ROW + (64 * kl + 8 * hh) * 2;
        bf16x8 A[4];
#pragma unroll
        for (int kp = 0; kp < 4; ++kp) A[kp] = *(const LAS bf16x8*)(arow + 32 * kp);
        const bf16x8 Z8 = {0, 0, 0, 0, 0, 0, 0, 0};
        f32x16 rt, it2;
#pragma unroll
        for (int i = 0; i < 16; ++i) { rt[i] = 0.f; it2[i] = 0.f; }
#pragma unroll
        for (int kp = 0; kp < 4; ++kp) { const bf16x8 Af = r_hD ? Z8 : A[kp]; rt = __builtin_amdgcn_mfma_f32_32x32x16_bf16(Af, Br[kp], rt, 0, 0, 0); it2 = __builtin_amdgcn_mfma_f32_32x32x16_bf16(Af, Bi[kp], it2, 0, 0, 0); }
#pragma unroll
        for (int kp = 0; kp < 4; ++kp) { const bf16x8 Ab = r_hD ? A[kp] : Z8; rt = __builtin_amdgcn_mfma_f32_32x32x16_bf16(Ab, Br[4 + kp], rt, 0, 0, 0); it2 = __builtin_amdgcn_mfma_f32_32x32x16_bf16(Ab, Bi[4 + kp], it2, 0, 0, 0); }
#pragma unroll
        for (int i = 0; i < 16; ++i) { const int tl = hh ? 63 - (16 * j + i) : 16 * j + i;
            const float xc = bf2f(*(const LAS bf16*)(xcI + tl * LRU_ROW + chl * 2));
            const float r = pg8::fast_sigmoid(rt[i] + bav), ig = pg8::fast_sigmoid(it2[i] + bxv);
            const float av = __builtin_amdgcn_exp2f(r * ls8), mult = __builtin_amdgcn_sqrtf(fmaxf(1.0f - av * av, 0.f));
            h = fmaf(av, h, mult * ig * xc);
            if (PASS == 1) P *= av;
            else { if (j < 2) hbuf[tl * 256 + chl] = h; else hbuf[tl * 256 + chl] += h; } }
    }
    if (PASS == 1) { float2 s; s.x = P; s.y = h; *(float2*)(LSUM + ((((size_t)b * 32 + cc) * 2 + hh) * WB + ch) * 2) = s; }
    else {
        __syncthreads();
#pragma unroll
        for (int e = tid; e < 64 * 32; e += NWAVES * 64) { const int tl = e >> 5, c8 = e & 31; const size_t m = m0 + tl;
            const LAS f32x4* hp = (const LAS f32x4*)(hbuf + tl * 256 + c8 * 8); const f32x4 h0 = hp[0], h1 = hp[1];
            const v4u gx = *(const GAS v4u*)(ZB + m * DM + 512 + ch2 * 256 + c8 * 8);
            v4u o; o.x = pk2(h0.x * pg8::bf_lo(gx.x), h0.y * pg8::bf_hi(gx.x)); o.y = pk2(h0.z * pg8::bf_lo(gx.y), h0.w * pg8::bf_hi(gx.y));
            o.z = pk2(h1.x * pg8::bf_lo(gx.z), h1.y * pg8::bf_hi(gx.z)); o.w = pk2(h1.z * pg8::bf_lo(gx.w), h1.w * pg8::bf_hi(gx.w));
            *(GAS v4u*)(YS + m * (4 * WB) + 2 * WB + ch2 * 256 + c8 * 8) = o; }
    }
    __syncthreads();
}
constexpr int PH_PER_LAYER = 9, PH_ADA = 0, PH_L0 = 1, PH_FIN = PH_L0 + PH_PER_LAYER * DEPTH, PH_COUNT = PH_FIN + 1;
enum { P_HN = 0, P_ZG = 1, P_MIX1 = 2, P_MIX2 = 3, P_BR = 4, P_WO = 5, P_H2 = 6, P_FF1 = 7, P_FF2 = 8 };
__global__ void __launch_bounds__(NWAVES * 64, 2) mk_fwd(Args args) {
    extern __shared__ __attribute__((aligned(16))) unsigned char lds[];
    Frame F;
    F.lds = (LAS unsigned char*)lds;
    F.MISC = (volatile LAS unsigned*)(F.lds + MISC_OFF);
    F.tid = threadIdx.x; F.lane = F.tid & 63; F.wave = __builtin_amdgcn_readfirstlane(F.tid >> 6);
    F.G = gridDim.x; { const int bx = blockIdx.x; F.vcu = (F.G % 8 == 0) ? (bx % 8) * (F.G / 8) + bx / 8 : bx; }
    unsigned char* ws = args.ws;
    F.ctl = (gu32*)(ws + WS_CTL);
    for (int u = F.tid; u < (LDS_BYTES - LDSCTL_OFF) / 4; u += NWAVES * 64) ((LAS unsigned*)(F.lds + LDSCTL_OFF))[u] = 0u;
    __syncthreads();
    XcdBarrier bar = xcd_barrier_post((unsigned*)(F.ctl + CW_BAR) + args.li * XCD_BAR_WORDS, F.MISC + 8);
    const int lo = args.ph_lo, hi = args.ph_hi;
#define IN(k) (lo <= (k) && (k) < hi)
#define SEAM(k) do { if (IN(k) && IN((k) + 1)) xcd_barrier(bar); } while (0)
    float* X = args.out;
    if (IN(PH_ADA)) { ada_phase(F, args.in[1], args.in[2], args.in[3], (float*)(ws + WS_MOD)); convert_weights(F, args, 0); small_weights(F, args, 0); lru_weights(F, args, 0); }
    SEAM(PH_ADA);
    const float* MOD = (const float*)(ws + WS_MOD);
    bf16* H = (bf16*)(ws + WS_H);
#pragma unroll 1
    for (int l = 0; l < DEPTH; ++l) {
        const int pb = PH_L0 + PH_PER_LAYER * l;
        const float* mod = MOD + (size_t)l * NB * 6 * DM;
        const float* xin = l == 0 ? args.in[0] : X;
        if (IN(pb + P_HN)) { if (l > 0) { convert_weights(F, args, l); small_weights(F, args, l); lru_weights(F, args, l); } normmod_rows(F, xin, args.in[4] + l * DM, mod + 1 * DM, mod + 0 * DM, H); }
        SEAM(pb + P_HN);
        if (IN(pb + P_ZG)) {
            pg8::Gemm g{H, (const bf16*)(opq(ws) + WS_WIN), M, DIN, DM}; pg8::StaticOrder S; S.init(M, DIN, F.G, opq_blk());
            pg8::EpiBf16x<1> E{(bf16*)(opq(ws) + WS_ZA), (bf16*)(opq(ws) + WS_ZB), (bf16*)(opq(ws) + WS_ZC), DM, DM, 1536};
            pg8::gemm_phase<pg8::EpiBf16x<1>, pg8::StaticOrder, PG8_ALIGN, PG8_SP2>(F.lds + RING_OFF, g, S, E);
        }
        SEAM(pb + P_ZG);
        if (IN(pb + P_MIX1)) {
            pool_phase(F, ws);
            gmlp_phase(F, args, l);
            for (int u = blockIdx.x; u < NB * 32; u += F.G) ssm_unit(F, args, l, u);
            for (int u = blockIdx.x; u < NB * 32 * 2; u += F.G) lru_unit<1>(F, args, l, u);
        }
        SEAM(pb + P_MIX1);
        if (IN(pb + P_MIX2)) {
            for (int u = blockIdx.x; u < NB * 32 * 2; u += F.G) lru_unit<2>(F, args, l, u);
            { pg8::Gemm g{(const bf16*)(opq(ws) + WS_YSSM), (const bf16*)(opq(ws) + WS_WGLU), M, WB, WB}; pg8::StaticOrder S; S.init(M, WB, F.G, opq_blk());
              pg8::EpiGlu E{(const bf16*)(opq(ws) + WS_YSSM), WB, (bf16*)(opq(ws) + WS_YS), 4 * WB, WB, args.in[17] + l * WB};
              pg8::gemm_phase<pg8::EpiGlu, pg8::StaticOrder, PG8_ALIGN, PG8_SP2>(F.lds + RING_OFF, g, S, E); }
            { pg8::Gemm g{H, (const bf16*)(opq(ws) + WS_WG), M, NGATE, DM}; pg8::StaticOrder S; S.init(M, NGATE, F.G, opq_blk());
              pg8::EpiGate E{opq(ws) + WS_GATES, NGATE / 256, args.in[30] + l * NGATE};
              pg8::gemm_phase<pg8::EpiGate, pg8::StaticOrder, PG8_ALIGN, PG8_SP2>(F.lds + RING_OFF, g, S, E); }
        }
        SEAM(pb + P_MIX2);
        if (IN(pb + P_BR)) {
            pg8::Gemm g{(const bf16*)(opq(ws) + WS_YS), (const bf16*)(opq(ws) + WS_WB), M, DM, 4 * WB}; pg8::StaticOrder S; S.init(M, DM, F.G, opq_blk());
            pg8::EpiBranch E{opq(ws) + WS_GATES, (bf16*)(opq(ws) + WS_MERGED), DM};
            pg8::gemm_phase<pg8::EpiBranch, pg8::StaticOrder, PG8_ALIGN, PG8_SP2>(F.lds + RING_OFF, g, S, E);
        }
        SEAM(pb + P_BR);
        if (IN(pb + P_WO)) {
            pg8::Gemm g{(const bf16*)(opq(ws) + WS_MERGED), (const bf16*)(opq(ws) + WS_WO), M, DM, DM}; pg8::StaticOrder S; S.init(M, DM, F.G, opq_blk());
            pg8::EpiRes E{xin, X, DM, mod + 2 * DM, 6 * DM, SEQ / 256};
            pg8::gemm_phase<pg8::EpiRes, pg8::StaticOrder, PG8_ALIGN, PG8_SP2>(F.lds + RING_OFF, g, S, E);
        }
        SEAM(pb + P_WO);
        if (IN(pb + P_H2)) normmod_rows(F, X, args.in[32] + l * DM, mod + 4 * DM, mod + 3 * DM, H);
        SEAM(pb + P_H2);
        if (IN(pb + P_FF1)) {
            pg8::Gemm g{H, (const bf16*)(opq(ws) + WS_W1), M, DFF, DM}; pg8::StaticOrder S; S.init(M, DFF, F.G, opq_blk());
            pg8::EpiBf16x<2> E{(bf16*)(opq(ws) + WS_F1), nullptr, nullptr, DFF, 0, 0};
            pg8::gemm_phase<pg8::EpiBf16x<2>, pg8::StaticOrder, PG8_ALIGN, PG8_SP2>(F.lds + RING_OFF, g, S, E);
        }
        SEAM(pb + P_FF1);
        if (IN(pb + P_FF2)) {
            pg8::Gemm g{(const bf16*)(opq(ws) + WS_F1), (const bf16*)(opq(ws) + WS_W2), M, DM, DFF}; pg8::StaticOrder S; S.init(M, DM, F.G, opq_blk());
            pg8::EpiRes E{X, X, DM, mod + 5 * DM, 6 * DM, SEQ / 256};
            pg8::gemm_phase<pg8::EpiRes, pg8::StaticOrder, PG8_ALIGN, PG8_SP2>(F.lds + RING_OFF, g, S, E);
        }
        SEAM(pb + P_FF2);
    }
    if (IN(PH_FIN)) final_rows(F, X, args.in[35]);
#undef IN
#undef SEAM
}

extern "C" void kernel_launch(void* const* d_in, const int* in_sizes, int n_in, void* d_out, int out_size, void* d_ws, size_t ws_size, hipStream_t stream) {
    static int grid = 0;
    if (grid == 0) {
        if (n_in != 36 || in_sizes[0] != M * DM || out_size != M * DM || ws_size < WS_END) { fprintf(stderr, "kernel_launch: unexpected problem: n_in %d in0 %d out %d ws %zu; nothing launched\n", n_in, n_in > 0 ? in_sizes[0] : -1, out_size, ws_size); grid = -1; return; }
        int dev = 0, cus = 0, per_cu = 0;
        if (hipGetDevice(&dev) != hipSuccess || hipDeviceGetAttribute(&cus, hipDeviceAttributeMultiprocessorCount, dev) != hipSuccess) { grid = -1; return; }
        if (hipFuncSetAttribute((const void*)mk_fwd, hipFuncAttributeMaxDynamicSharedMemorySize, LDS_BYTES) != hipSuccess) { fprintf(stderr, "kernel_launch: hipFuncSetAttribute failed\n"); grid = -1; return; }
        if (hipOccupancyMaxActiveBlocksPerMultiprocessor(&per_cu, (const void*)mk_fwd, NWAVES * 64, LDS_BYTES) != hipSuccess || per_cu < 1) fprintf(stderr, "kernel_launch: occupancy query says %d\n", per_cu);
        (void)hipGetLastError();
        grid = cus;
        fprintf(stderr, "kernel_launch: grid %d (occupancy query %d per CU), ws %zu bytes\n", grid, per_cu, ws_size);
    }
    if (grid < 0) return;
    unsigned char* ws = (unsigned char*)d_ws;
    (void)hipMemsetAsync(ws + WS_CTL, 0, CTL_ZERO_BYTES, stream);
    Args a{};
    for (int i = 0; i < 36; ++i) a.in[i] = (const float*)d_in[i];
    a.out = (float*)d_out; a.ws = ws; a.ph_lo = 0; a.ph_hi = PH_COUNT; a.li = 0;
    hipLaunchKernelGGL(mk_fwd, dim3(grid), dim3(NWAVES * 64), LDS_BYTES, stream, a);
}
```
